# Optimizing an MI355X kernel written in HIP

```python
import jax, jax.numpy as jnp
from jax import lax
import numpy as np

D_MODEL = 1024
BATCH = 4
SEQ = 8192
DEPTH = 1

HEAD_DIM = 64
SWA_Q_HEADS = 8
SWA_KV_HEADS = 2
SWA_GROUP = SWA_Q_HEADS // SWA_KV_HEADS
SWA_WIDTH = SWA_Q_HEADS * HEAD_DIM
SWA_KV_WIDTH = SWA_KV_HEADS * HEAD_DIM
FOX_HEADS = 8
FOX_WIDTH = FOX_HEADS * HEAD_DIM
WINDOW = 128
BLOCK = 128
ROPE_THETA = 10000.0
NORM_EPS = 1e-6
FORGET_BIAS_INIT = 2.0

IN_SPLITS = (SWA_WIDTH, SWA_KV_WIDTH, SWA_KV_WIDTH, SWA_WIDTH,
             FOX_WIDTH, FOX_WIDTH, FOX_WIDTH, FOX_HEADS, FOX_WIDTH,
             D_MODEL, D_MODEL)
IN_WIDTH = sum(IN_SPLITS)

kernel_name = "hybrid_swa_sink_fox_gated_block"


def rms_norm(x, g):
    xf = x.astype(jnp.float32)
    y = xf * lax.rsqrt(jnp.mean(xf * xf, axis=-1, keepdims=True) + NORM_EPS)
    return (y * g.astype(jnp.float32)).astype(x.dtype)


def rope_tables(positions):
    inv_freq = ROPE_THETA ** (-jnp.arange(0, HEAD_DIM, 2, dtype=jnp.float32) / HEAD_DIM)
    ang = positions.astype(jnp.float32)[..., None] * inv_freq
    ang = jnp.concatenate([ang, ang], axis=-1)[:, :, None, :]
    return jnp.cos(ang), jnp.sin(ang)


def apply_rope(t, cos, sin):
    half = HEAD_DIM // 2
    tf = t.astype(jnp.float32)
    rot = jnp.concatenate([-tf[..., half:], tf[..., :half]], axis=-1)
    return (tf * cos + rot * sin).astype(t.dtype)


def split_cols(p, sizes):
    offs = np.cumsum(sizes)[:-1].tolist()
    return jnp.split(p, offs, axis=-1)


def sliding_window_gqa_sinks(q, k, v, sinks):
    b, s = q.shape[:2]
    nb = s // BLOCK
    q = q.reshape(b, nb, BLOCK, SWA_KV_HEADS, SWA_GROUP, HEAD_DIM)
    k = k.reshape(b, nb, BLOCK, SWA_KV_HEADS, HEAD_DIM)
    v = v.reshape(b, nb, BLOCK, SWA_KV_HEADS, HEAD_DIM)
    pad_k = jnp.zeros_like(k[:, :1])
    pad_v = jnp.zeros_like(v[:, :1])
    k_band = jnp.concatenate([jnp.concatenate([pad_k, k[:, :-1]], axis=1), k], axis=2)
    v_band = jnp.concatenate([jnp.concatenate([pad_v, v[:, :-1]], axis=1), v], axis=2)
    logits = jnp.einsum('bnqkgd,bnskd->bnkgqs', q, k_band).astype(jnp.float32) * (HEAD_DIM ** -0.5)
    blk = jnp.arange(nb)[:, None, None]
    qpos = blk * BLOCK + jnp.arange(BLOCK)[None, :, None]
    kpos = (blk - 1) * BLOCK + jnp.arange(2 * BLOCK)[None, None, :]
    rel = qpos - kpos
    mask = (rel >= 0) & (rel < WINDOW) & (kpos >= 0)
    logits = jnp.where(mask[None, :, None, None], logits, -jnp.inf)
    sink = sinks.astype(jnp.float32).reshape(SWA_KV_HEADS, SWA_GROUP)[None, None, :, :, None, None]
    m = jnp.maximum(jnp.max(logits, axis=-1, keepdims=True), sink)
    p = jnp.exp(logits - m)
    denom = jnp.sum(p, axis=-1, keepdims=True) + jnp.exp(sink - m)
    out = jnp.einsum('bnkgqs,bnskd->bnqkgd', (p / denom).astype(v.dtype), v_band)
    return out.reshape(b, s, SWA_WIDTH)


def forgetting_attention(q, k, v, cum):
    b, s = q.shape[:2]
    nb = s // BLOCK
    q_blocks = q.reshape(b, nb, BLOCK, FOX_HEADS, HEAD_DIM).transpose(1, 0, 2, 3, 4)
    cq_blocks = cum.reshape(b, nb, BLOCK, FOX_HEADS).transpose(1, 0, 3, 2)
    ck = cum.transpose(0, 2, 1)[:, :, None, :]
    kpos = jnp.arange(s)
    scale = HEAD_DIM ** -0.5

    def one_block(args):
        qb, cqb, n = args
        logits = jnp.einsum('bqhd,bshd->bhqs', qb, k).astype(jnp.float32) * scale
        logits = logits + cqb[..., None] - ck
        qpos = n * BLOCK + jnp.arange(BLOCK)
        mask = kpos[None, :] <= qpos[:, None]
        logits = jnp.where(mask, logits, -jnp.inf)
        p = jax.nn.softmax(logits, axis=-1)
        return jnp.einsum('bhqs,bshd->bqhd', p.astype(v.dtype), v)

    out = lax.map(one_block, (q_blocks, cq_blocks, jnp.arange(nb)))
    return out.transpose(1, 0, 2, 3, 4).reshape(b, s, FOX_WIDTH)


def setup_inputs(seed: int = 0) -> dict:
    key = jax.random.key(seed)
    ks = jax.random.split(key, 14)
    f32 = jnp.float32
    x = jax.random.normal(ks[0], (BATCH, SEQ, D_MODEL), f32)
    c = jax.random.normal(ks[1], (BATCH, D_MODEL), f32)
    positions = jnp.broadcast_to(jnp.arange(SEQ, dtype=jnp.int32), (BATCH, SEQ))
    w_ada = jax.random.normal(ks[2], (DEPTH, D_MODEL, 3 * D_MODEL), f32) * (0.5 * D_MODEL ** -0.5)
    b_ada = jax.random.normal(ks[3], (DEPTH, 3 * D_MODEL), f32) * 0.02
    g_norm = 1.0 + 0.05 * jax.random.normal(ks[4], (DEPTH, D_MODEL), f32)
    w_in = jax.random.normal(ks[5], (DEPTH, D_MODEL, IN_WIDTH), f32) * D_MODEL ** -0.5
    b_f = FORGET_BIAS_INIT + 0.1 * jax.random.normal(ks[6], (DEPTH, FOX_HEADS), f32)
    sinks = jax.random.normal(ks[7], (DEPTH, SWA_Q_HEADS), f32) * 0.5
    w_o_swa = jax.random.normal(ks[8], (DEPTH, SWA_WIDTH, D_MODEL), f32) * SWA_WIDTH ** -0.5
    w_o_fox = jax.random.normal(ks[9], (DEPTH, FOX_WIDTH, D_MODEL), f32) * FOX_WIDTH ** -0.5
    w_out = jax.random.normal(ks[10], (DEPTH, D_MODEL, D_MODEL), f32) * D_MODEL ** -0.5
    g_final = 1.0 + 0.05 * jax.random.normal(ks[11], (D_MODEL,), f32)
    return {"x": x, "c": c, "positions": positions, "w_ada": w_ada, "b_ada": b_ada,
            "g_norm": g_norm, "w_in": w_in, "b_f": b_f, "sinks": sinks,
            "w_o_swa": w_o_swa, "w_o_fox": w_o_fox, "w_out": w_out, "g_final": g_final}


def reference(x, c, positions, w_ada, b_ada, g_norm, w_in, b_f, sinks, w_o_swa, w_o_fox, w_out, g_final):
    b, s, _ = x.shape
    cos, sin = rope_tables(positions)
    for l in range(DEPTH):
        ada = c @ w_ada[l] + b_ada[l]
        shift, scale, gate = jnp.split(ada, 3, axis=-1)
        h = rms_norm(x, g_norm[l]) * (1.0 + scale[:, None, :]) + shift[:, None, :]
        proj = h @ w_in[l]
        qa, ka, va, za, qb, kb, vb, fb, zb, ga, gb = split_cols(proj, IN_SPLITS)
        qa = apply_rope(qa.reshape(b, s, SWA_Q_HEADS, HEAD_DIM), cos, sin)
        ka = apply_rope(ka.reshape(b, s, SWA_KV_HEADS, HEAD_DIM), cos, sin)
        va = va.reshape(b, s, SWA_KV_HEADS, HEAD_DIM)
        att_a = sliding_window_gqa_sinks(qa, ka, va, sinks[l])
        y_a = (att_a * jax.nn.silu(za)) @ w_o_swa[l]
        log_f = jax.nn.log_sigmoid(fb.astype(jnp.float32) + b_f[l].astype(jnp.float32))
        cum = jnp.cumsum(log_f, axis=1)
        att_b = forgetting_attention(qb.reshape(b, s, FOX_HEADS, HEAD_DIM),
                                     kb.reshape(b, s, FOX_HEADS, HEAD_DIM),
                                     vb.reshape(b, s, FOX_HEADS, HEAD_DIM), cum)
        y_b = (att_b * jax.nn.silu(zb)) @ w_o_fox[l]
        merged = jax.nn.sigmoid(ga) * y_a + jax.nn.sigmoid(gb) * y_b
        x = x + gate[:, None, :] * (merged @ w_out[l])
    return rms_norm(x, g_final)
```

```cpp
#include <hip/hip_runtime.h>
#include <hip/hip_cooperative_groups.h>
#include <cstdio>
#include <cstdint>
namespace cg = cooperative_groups;
namespace pg8 {
#define PG8_LAS __attribute__((address_space(3)))
typedef unsigned short bf16_t;
typedef short bf16x8 __attribute__((ext_vector_type(8)));
typedef float f32x4 __attribute__((ext_vector_type(4)));
typedef unsigned u32x4 __attribute__((ext_vector_type(4)));
typedef unsigned u32x2 __attribute__((ext_vector_type(2)));
constexpr int BM = 256, BK = 64, HALF = 128, HTB = HALF * BK * 2  , STAGE_BYTES = 8 * HTB, NXCD = 8, WGM = 8;

__host__ __device__ __forceinline__ int lds_byte(int r, int c) { const int st = (r >> 4) * 2 + (c >> 5), rr = r & 15, cc = c & 31, ob = rr * 64 + cc * 2; return st * 1024 + (ob ^ (((ob >> 9) & 1) << 5)); }
__host__ __device__ __forceinline__ void stage_rc(int b, int& R, int& C) { const int st = b / 1024, sb = b % 1024, swz = sb ^ (((sb >> 9) & 1) << 5); R = (st >> 1) * 16 + swz / 64; C = (st & 1) * 32 + (swz % 64) / 2; }
__host__ __device__ __forceinline__ int perm32(int rho) { const int n = rho >> 4, i = rho & 15; return 8 * (i >> 2) + 4 * n + (i & 3); }

struct Unit { int pm, pn, z; };
struct Gemm { const bf16_t* A; const bf16_t* Bt; const bf16_t* A2; const bf16_t* Bt2; int lda, M, N, K; };

struct StaticOrder {
    int nM, nN, nwg, G, c, nz;
    __host__ __device__ void init(int M, int N, int G_, int c_, int nz_) { nM = M / BM; nN = N / BM; nwg = nM * nN; G = G_; c = c_; nz = nz_; }
    __host__ __device__ bool next(int i, Unit& u) const {
        const int it = (nz == 2) ? (i >> 1) : i; u.z = (nz == 2) ? (i & 1) : 0;
        const long L = (long)it * G + c; if (L >= nwg) return false;
        int wgid = (int)L; { const int q = nwg / NXCD, r = nwg % NXCD, xcd = wgid % NXCD, off = wgid / NXCD; wgid = (xcd < r ? xcd * (q + 1) : r * (q + 1) + (xcd - r) * q) + off; }
        const int nig = WGM * nN, gid = wgid / nig, fm = gid * WGM, gsz = (nM - fm) < WGM ? (nM - fm) : WGM;
        u.pm = fm + ((wgid % nig) % gsz); u.pn = (wgid % nig) / gsz; return true;
    }
    __device__ __forceinline__ void a_ready(const Unit&) const {}
    __device__ __forceinline__ void done(const Unit&) const {}
};

__device__ __forceinline__ unsigned cvt_pk_bf16(float lo, float hi) { unsigned r; asm volatile("v_cvt_pk_bf16_f32 %0, %1, %2" : "=v"(r) : "v"(lo), "v"(hi)); return r; }
__device__ __forceinline__ float bf_lo(unsigned u) { return __uint_as_float(u << 16); }
__device__ __forceinline__ float bf_hi(unsigned u) { return __uint_as_float(u & 0xffff0000u); }
__device__ __forceinline__ float sigmoidf_(float v) { return __builtin_amdgcn_rcpf(1.0f + __builtin_amdgcn_exp2f(-1.4426950408889634f * v)); }

constexpr int PJW = 5376;
constexpr float QC2 = 0.125f * 1.4426950408889634f;
struct EpiProj {
    static constexpr bool PERM = true, AFTER_DRAIN = false;
    bf16_t* O; const float* rope;
    __device__ __forceinline__ void operator()(const f32x4 (&acc)[2][2][4][2], const Unit& u, int wr, int wc, int fr, int fq) const {
        const int row0 = u.pm * BM + wr * 64 + fr;
#pragma unroll
        for (int bj = 0; bj < 2; ++bj) {
            const int hx = 2 * u.pn + bj;
            if (hx < 5) {
                const float sc = hx < 4 ? QC2 : 1.0f; const int d0 = 16 * (wc & 1) + 4 * fq; const int colb = hx * HALF + 64 * (wc >> 1) + d0;
#pragma unroll
                for (int ai = 0; ai < 2; ++ai)
#pragma unroll
                    for (int m = 0; m < 4; ++m) { const int row = row0 + ai * HALF + m * 16; const f32x4* rp = (const f32x4*)(rope + (size_t)row * 64 + 2 * d0);
                        const f32x4 cs0 = rp[0], cs1 = rp[1]; const f32x4 v0 = acc[ai][bj][m][0], v1 = acc[ai][bj][m][1];
                        const float c0 = cs0[0], s0 = cs0[1], c1 = cs0[2], s1 = cs0[3], c2 = cs1[0], s2 = cs1[1], c3 = cs1[2], s3 = cs1[3];
                        u32x2 lo, hi;
                        lo.x = cvt_pk_bf16((v0[0] * c0 - v1[0] * s0) * sc, (v0[1] * c1 - v1[1] * s1) * sc); lo.y = cvt_pk_bf16((v0[2] * c2 - v1[2] * s2) * sc, (v0[3] * c3 - v1[3] * s3) * sc);
                        hi.x = cvt_pk_bf16((v1[0] * c0 + v0[0] * s0) * sc, (v1[1] * c1 + v0[1] * s1) * sc); hi.y = cvt_pk_bf16((v1[2] * c2 + v0[2] * s2) * sc, (v1[3] * c3 + v0[3] * s3) * sc);
                        bf16_t* rowp = O + (size_t)row * PJW + colb; *(u32x2*)rowp = lo; *(u32x2*)(rowp + 32) = hi; }
            } else {
                const int op = (hx == 5 || (hx >= 14 && hx < 22)) ? 0 : (hx >= 10 && hx < 14) ? 1 : (hx < 26) ? 2 : 3;
                const int col0 = hx * HALF + wc * 32 + 8 * fq;
#pragma unroll
                for (int ai = 0; ai < 2; ++ai)
#pragma unroll
                    for (int m = 0; m < 4; ++m) { const int row = row0 + ai * HALF + m * 16; f32x4 v0 = acc[ai][bj][m][0], v1 = acc[ai][bj][m][1];
                        if (op == 1) { v0 = v0 * QC2; v1 = v1 * QC2; }
                        else if (op >= 2) {
#pragma unroll
                            for (int e = 0; e < 4; ++e) { const float s0 = sigmoidf_(v0[e]), s1 = sigmoidf_(v1[e]); v0[e] = op == 2 ? v0[e] * s0 : s0; v1[e] = op == 2 ? v1[e] * s1 : s1; } }
                        u32x4 w; w.x = cvt_pk_bf16(v0[0], v0[1]); w.y = cvt_pk_bf16(v0[2], v0[3]); w.z = cvt_pk_bf16(v1[0], v1[1]); w.w = cvt_pk_bf16(v1[2], v1[3]);
                        *(u32x4*)(O + (size_t)row * PJW + col0) = w; }
            }
        }
    }
};
struct EpiMerge {
    static constexpr bool PERM = true, AFTER_DRAIN = false;
    const bf16_t* PJ; bf16_t* MG;
    __device__ __forceinline__ void operator()(const f32x4 (&acc)[2][2][4][2], const Unit& u, int wr, int wc, int fr, int fq) const {
        const int row0 = u.pm * BM + wr * 64 + fr, col0 = u.pn * BM + wc * 32 + 8 * fq, gc0 = 3328 + u.z * 1024 + col0;
#pragma unroll
        for (int ai = 0; ai < 2; ++ai)
#pragma unroll
            for (int m = 0; m < 4; ++m) { const int row = row0 + ai * HALF + m * 16;
#pragma unroll
                for (int bj = 0; bj < 2; ++bj) { const u32x4 g = *(const u32x4*)(PJ + (size_t)row * PJW + gc0 + bj * HALF); bf16_t* dst = MG + (size_t)row * 1024 + col0 + bj * HALF;
                    f32x4 v0 = acc[ai][bj][m][0], v1 = acc[ai][bj][m][1];
                    v0[0] *= bf_lo(g.x); v0[1] *= bf_hi(g.x); v0[2] *= bf_lo(g.y); v0[3] *= bf_hi(g.y); v1[0] *= bf_lo(g.z); v1[1] *= bf_hi(g.z); v1[2] *= bf_lo(g.w); v1[3] *= bf_hi(g.w);
                    if (u.z) { const u32x4 p = *(const u32x4*)dst; v0[0] += bf_lo(p.x); v0[1] += bf_hi(p.x); v0[2] += bf_lo(p.y); v0[3] += bf_hi(p.y); v1[0] += bf_lo(p.z); v1[1] += bf_hi(p.z); v1[2] += bf_lo(p.w); v1[3] += bf_hi(p.w); }
                    u32x4 w; w.x = cvt_pk_bf16(v0[0], v0[1]); w.y = cvt_pk_bf16(v0[2], v0[3]); w.z = cvt_pk_bf16(v1[0], v1[1]); w.w = cvt_pk_bf16(v1[2], v1[3]);
                    *(u32x4*)dst = w; } }
    }
};
struct EpiOut {
    static constexpr bool PERM = true, AFTER_DRAIN = false;
    const float* x; const float* gate; float* out; float* rss;
    __device__ __forceinline__ void operator()(const f32x4 (&acc)[2][2][4][2], const Unit& u, int wr, int wc, int fr, int fq) const {
        const int row0 = u.pm * BM + wr * 64 + fr, col0 = u.pn * BM + wc * 32 + 8 * fq; const float* gp = gate + (u.pm >> 5) * 1024 + col0;
        f32x4 gv[2][2];
#pragma unroll
        for (int bj = 0; bj < 2; ++bj)
#pragma unroll
            for (int n = 0; n < 2; ++n) gv[bj][n] = *(const f32x4*)(gp + bj * HALF + 4 * n);
#pragma unroll
        for (int ai = 0; ai < 2; ++ai)
#pragma unroll
            for (int m = 0; m < 4; ++m) { const int row = row0 + ai * HALF + m * 16; const size_t off = (size_t)row * 1024 + col0; float ss = 0.f;
#pragma unroll
                for (int bj = 0; bj < 2; ++bj)
#pragma unroll
                    for (int n = 0; n < 2; ++n) { const f32x4 xv = *(const f32x4*)(x + off + bj * HALF + 4 * n); const f32x4 o = xv + gv[bj][n] * acc[ai][bj][m][n];
                        *(f32x4*)(out + off + bj * HALF + 4 * n) = o; ss += (o[0] * o[0] + o[1] * o[1]) + (o[2] * o[2] + o[3] * o[3]); }
                ss += __shfl_xor(ss, 16); ss += __shfl_xor(ss, 32);
                if (fq == 0) rss[(size_t)row * 16 + u.pn * 4 + wc] = ss; }
    }
};

template <class Epi, class Sched, bool ALIGN_EPI = false, bool SP2 = false>
__device__ __forceinline__ void gemm_phase(PG8_LAS unsigned char* lds, const Gemm g, const Sched& S, const Epi& E) {
    int tid_ = threadIdx.x; asm volatile("" : "+v"(tid_));
    const int tid = tid_, wid = __builtin_amdgcn_readfirstlane(tid >> 6), lane = tid & 63, wr = wid >> 2, wc = wid & 3, fr = lane & 15, fq = lane >> 4;
    const int K = g.K, nt = K / BK;
    unsigned voffA[2], voffB[2];
#pragma unroll
    for (int i = 0; i < 2; ++i) { int R, C; stage_rc(tid * 16 + i * 8192, R, C); const int Rb = Epi::PERM ? ((R & ~31) + perm32(R & 31)) : R;
        voffA[i] = (unsigned)(R * g.lda + C) * 2u; voffB[i] = (unsigned)(Rb * K + C) * 2u; }
    const size_t kstep = (size_t)(BK * 2);
    const size_t hstepA = (size_t)HALF * g.lda * 2, hstepB = (size_t)HALF * K * 2;
    const size_t tstepA = 2 * hstepA, tstepB = 2 * hstepB;
    const unsigned ldsw = (unsigned)wid * 1024u;
    const int aoff = lds_byte(wr * 64 + fr, fq * 8), boff = lds_byte(wc * 32 + fr, fq * 8);
#define PG8_SA(b, h) (((b) * 2 + (h)) * HTB)
#define PG8_SB(b, h) ((4 + (b) * 2 + (h)) * HTB)
#define PG8_STAGE(bufoff, gbase, voff) do { _Pragma("unroll") for (int _i = 0; _i < 2; ++_i) \
        __builtin_amdgcn_global_load_lds((const unsigned*)((const char*)(gbase) + (voff)[_i]), (PG8_LAS unsigned*)(lds + (bufoff) + ldsw + _i * 8192), 16, 0, 0); } while (0)
#define PG8_LDA(dst, b, h) do { _Pragma("unroll") for (int m = 0; m < 4; ++m) _Pragma("unroll") for (int k = 0; k < 2; ++k) dst[m][k] = *(const PG8_LAS bf16x8*)(lds + PG8_SA(b, h) + aoff + m * 2048 + k * 1024); } while (0)
#define PG8_LDB(dst, b, h) do { _Pragma("unroll") for (int n = 0; n < 2; ++n) _Pragma("unroll") for (int k = 0; k < 2; ++k) dst[n][k] = *(const PG8_LAS bf16x8*)(lds + PG8_SB(b, h) + boff + n * 2048 + k * 1024); } while (0)
#define PG8_MMA(ai, bj, At, Bt) do { __builtin_amdgcn_s_setprio(1); _Pragma("unroll") for (int m = 0; m < 4; ++m) _Pragma("unroll") for (int n = 0; n < 2; ++n) _Pragma("unroll") for (int k = 0; k < 2; ++k) \
        acc[ai][bj][m][n] = __builtin_amdgcn_mfma_f32_16x16x32_bf16(Bt[n][k], At[m][k], acc[ai][bj][m][n], 0, 0, 0); __builtin_amdgcn_s_setprio(0); } while (0)
#define PG8_WAIT_V(n) asm volatile("s_waitcnt vmcnt(" #n ")" ::: "memory")
#define PG8_WAIT_L(n) asm volatile("s_waitcnt lgkmcnt(" #n ")" ::: "memory")
#define PG8_BAR __builtin_amdgcn_s_barrier()
#define PG8_SCHED __builtin_amdgcn_sched_barrier(0)
    Unit cur, nxt; int ui = 0;
    if (!S.next(0, cur)) return;
    f32x4 acc[2][2][4][2];
#pragma unroll
    for (int a = 0; a < 2; ++a)
#pragma unroll
        for (int b = 0; b < 2; ++b)
#pragma unroll
            for (int m = 0; m < 4; ++m)
#pragma unroll
                for (int n = 0; n < 2; ++n) acc[a][b][m][n] = (f32x4){0.f, 0.f, 0.f, 0.f};
    bf16x8 At[4][2], B0[2][2], B1[2][2];
    const char* cA = (const char*)(cur.z ? g.A2 : g.A) + (size_t)cur.pm * tstepA; const char* cB = (const char*)(cur.z ? g.Bt2 : g.Bt) + (size_t)cur.pn * tstepB;
    S.a_ready(cur);
    if constexpr (SP2) {
        PG8_STAGE(PG8_SB(0, 0), cB, voffB); PG8_STAGE(PG8_SB(0, 1), cB + hstepB, voffB); PG8_STAGE(PG8_SA(0, 0), cA, voffA); PG8_STAGE(PG8_SA(0, 1), cA + hstepA, voffA);
        if (wr == 1) PG8_BAR;
        PG8_WAIT_V(2); PG8_BAR;
        PG8_STAGE(PG8_SB(1, 0), cB + kstep, voffB); PG8_STAGE(PG8_SA(1, 0), cA + kstep, voffA); PG8_STAGE(PG8_SB(1, 1), cB + hstepB + kstep, voffB);
        PG8_WAIT_V(6); PG8_BAR;
    } else {
        PG8_STAGE(PG8_SB(0, 0), cB, voffB); PG8_STAGE(PG8_SA(0, 0), cA, voffA); PG8_STAGE(PG8_SB(0, 1), cB + hstepB, voffB); PG8_STAGE(PG8_SA(0, 1), cA + hstepA, voffA);
        if (wr == 1) PG8_BAR;
        PG8_WAIT_V(4); PG8_BAR;
        PG8_STAGE(PG8_SB(1, 0), cB + kstep, voffB); PG8_STAGE(PG8_SA(1, 0), cA + kstep, voffA); PG8_STAGE(PG8_SB(1, 1), cB + hstepB + kstep, voffB);
        PG8_WAIT_V(6); PG8_BAR;
    }
    for (;;) {
        const bool has_next = S.next(ui + 1, nxt);
        const char* nA = has_next ? (const char*)(nxt.z ? g.A2 : g.A) + (size_t)nxt.pm * tstepA : cA; const char* nB = has_next ? (const char*)(nxt.z ? g.Bt2 : g.Bt) + (size_t)nxt.pn * tstepB : cB;
        for (int t = 0; t < nt; t += 2) {
            const bool last = (t == nt - 2);
            const char* a1 = cA + (size_t)(t + 1) * kstep;
            const char* a2 = last ? nA : cA + (size_t)(t + 2) * kstep; const char* b2 = last ? nB : cB + (size_t)(t + 2) * kstep;
            const char* a3 = a2 + kstep; const char* b3 = b2 + kstep;
            if (last && has_next) S.a_ready(nxt);
            if constexpr (SP2) {
            PG8_LDB(B0, 0, 0); PG8_LDB(B1, 0, 1); PG8_SCHED; PG8_LDA(At, 0, 0); PG8_STAGE(PG8_SA(1, 1), a1 + hstepA, voffA);
            PG8_WAIT_V(8); PG8_WAIT_L(0); PG8_BAR; PG8_MMA(0, 0, At, B0); PG8_MMA(0, 1, At, B1); PG8_BAR; PG8_SCHED;
            PG8_LDA(At, 0, 1); PG8_STAGE(PG8_SB(0, 0), b2, voffB); PG8_STAGE(PG8_SB(0, 1), b2 + hstepB, voffB); PG8_STAGE(PG8_SA(0, 0), a2, voffA);
            PG8_WAIT_V(8); PG8_WAIT_L(0); PG8_BAR; PG8_MMA(1, 0, At, B0); PG8_MMA(1, 1, At, B1); PG8_BAR; PG8_SCHED;
            PG8_LDB(B0, 1, 0); PG8_LDB(B1, 1, 1); PG8_SCHED; PG8_LDA(At, 1, 0); PG8_STAGE(PG8_SA(0, 1), a2 + hstepA, voffA);
            PG8_WAIT_V(8); PG8_WAIT_L(0); PG8_BAR; PG8_MMA(0, 0, At, B0); PG8_MMA(0, 1, At, B1); PG8_BAR; PG8_SCHED;
            PG8_LDA(At, 1, 1); PG8_STAGE(PG8_SB(1, 0), b3, voffB); PG8_STAGE(PG8_SB(1, 1), b3 + hstepB, voffB); PG8_STAGE(PG8_SA(1, 0), a3, voffA);
            PG8_WAIT_V(8); PG8_WAIT_L(0); PG8_BAR; PG8_MMA(1, 0, At, B0); PG8_MMA(1, 1, At, B1); PG8_BAR; PG8_SCHED;
            } else {
            PG8_LDB(B0, 0, 0); PG8_SCHED; PG8_LDA(At, 0, 0); PG8_STAGE(PG8_SA(1, 1), a1 + hstepA, voffA);
            PG8_WAIT_L(8); PG8_BAR; PG8_WAIT_L(0); PG8_MMA(0, 0, At, B0); PG8_BAR; PG8_SCHED;
            PG8_LDB(B1, 0, 1); PG8_STAGE(PG8_SB(0, 0), b2, voffB);
            PG8_BAR; PG8_WAIT_L(0); PG8_MMA(0, 1, At, B1); PG8_BAR;
            PG8_LDA(At, 0, 1); PG8_STAGE(PG8_SA(0, 0), a2, voffA);
            PG8_BAR; PG8_WAIT_L(0); PG8_MMA(1, 0, At, B0); PG8_BAR; PG8_SCHED;
            PG8_STAGE(PG8_SB(0, 1), b2 + hstepB, voffB);
            PG8_WAIT_V(6); PG8_BAR; PG8_MMA(1, 1, At, B1); PG8_BAR;
            PG8_LDB(B0, 1, 0); PG8_SCHED; PG8_LDA(At, 1, 0); PG8_STAGE(PG8_SA(0, 1), a2 + hstepA, voffA);
            PG8_WAIT_L(8); PG8_BAR; PG8_WAIT_L(0); PG8_MMA(0, 0, At, B0); PG8_BAR; PG8_SCHED;
            PG8_LDB(B1, 1, 1); PG8_STAGE(PG8_SB(1, 0), b3, voffB);
            PG8_BAR; PG8_WAIT_L(0); PG8_MMA(0, 1, At, B1); PG8_BAR;
            PG8_LDA(At, 1, 1); PG8_STAGE(PG8_SA(1, 0), a3, voffA);
            PG8_BAR; PG8_WAIT_L(0); PG8_MMA(1, 0, At, B0); PG8_BAR; PG8_SCHED;
            PG8_STAGE(PG8_SB(1, 1), b3 + hstepB, voffB);
            PG8_WAIT_V(6); PG8_BAR; PG8_MMA(1, 1, At, B1); PG8_BAR;
            }
        }
        if constexpr (ALIGN_EPI) { if (wr == 0) PG8_BAR; }
        if constexpr (!Epi::AFTER_DRAIN) { E(acc, cur, wr, wc, fr, fq); S.done(cur); }
        if (!has_next) break;
#pragma unroll
        for (int a = 0; a < 2; ++a)
#pragma unroll
            for (int b = 0; b < 2; ++b)
#pragma unroll
                for (int m = 0; m < 4; ++m)
#pragma unroll
                    for (int n = 0; n < 2; ++n) acc[a][b][m][n] = (f32x4){0.f, 0.f, 0.f, 0.f};
        cur = nxt; cA = nA; cB = nB; ++ui;
        if constexpr (ALIGN_EPI) { if (wr == 1) PG8_BAR; }
    }
    PG8_WAIT_V(0);
    if constexpr (!ALIGN_EPI) { if (wr == 0) PG8_BAR; }
    PG8_BAR;
    if constexpr (Epi::AFTER_DRAIN) { E.fused(acc, cur, wr, wc, fr, fq, lds, wid, lane); S.done(cur); }
#undef PG8_SA
#undef PG8_SB
#undef PG8_STAGE
#undef PG8_LDA
#undef PG8_LDB
#undef PG8_MMA
#undef PG8_WAIT_V
#undef PG8_WAIT_L
#undef PG8_BAR
#undef PG8_SCHED
}
}

#include <hip/hip_bf16.h>
#include <cmath>
namespace attn_body {
using bf16=__hip_bfloat16;
using bf16x8=__attribute__((ext_vector_type(8)))short;
using s16x4=__attribute__((ext_vector_type(4)))short;
using f32x16=__attribute__((ext_vector_type(16)))float;
using u32x4=__attribute__((ext_vector_type(4)))unsigned;
constexpr int BATCH=4,NHEAD=8,SEQ=8192,D=64,DM=5376;
constexpr int NW=8,QBLK=32,QB=QBLK*NW,KVBLK=64,NQB=SEQ/QB;
constexpr int ATTN_PITCH=DM, ATTN_UNIT_ROWS=QB;
__device__ __forceinline__ int crow(int r,int hi){return (r&3)+8*(r>>2)+4*hi;}
#define SBAR() __builtin_amdgcn_sched_barrier(0)
__device__ __forceinline__ void cmask(f32x16&p0,f32x16&p1,int jb,int qrel,int hi){
  const float NEG=-INFINITY; int kb=64*jb+4*hi;
  #pragma unroll
  for(int r=0;r<16;++r){int kv=kb+(r&3)+8*(r>>2); if(kv>qrel)p0[r]=NEG; if(kv+32>qrel)p1[r]=NEG;}
}

constexpr int NSLOT=3, SLOTB=8192;
constexpr int LDS_K=0, LDS_V=NSLOT*SLOTB, LDS_WS=2*NSLOT*SLOTB, LDS_OST=LDS_WS+NW*64*4, LDS_CB=LDS_OST+NW*4096, LDS_BYTES=LDS_CB+SEQ*4;
constexpr float C2=0.125f*1.4426950408889634f;
__device__ __forceinline__ void glds16(const void*gsrc,unsigned lds_dst){unsigned keep;
  asm volatile("s_mov_b32 %0, m0\n\ts_mov_b32 m0, %2\n\ts_nop 0\n\tglobal_load_lds_dwordx4 %1, off\n\ts_mov_b32 m0, %0":"=&s"(keep):"v"(gsrc),"s"(lds_dst):"memory");}
__device__ __forceinline__ float max3f(float a,float b,float c){float r;asm("v_max3_f32 %0, %1, %2, %3":"=v"(r):"v"(a),"v"(b),"v"(c));return r;}
__device__ __forceinline__ float max2f(float a,float b){float r;asm("v_max_f32_e32 %0, %1, %2":"=v"(r):"v"(a),"v"(b));return r;}
__device__ __forceinline__ float fadd_s(float a,float b){float r;asm("v_add_f32_e32 %0, %1, %2":"=v"(r):"v"(a),"v"(b));return r;}
__device__ __forceinline__ float fsub_s(float a,float b){float r;asm("v_sub_f32_e32 %0, %1, %2":"=v"(r):"v"(a),"v"(b));return r;}
typedef float f32x2_t __attribute__((ext_vector_type(2))); typedef __bf16 bf16x2_t __attribute__((ext_vector_type(2)));
__device__ __forceinline__ unsigned cvtpk_s(float lo,float hi){f32x2_t v={lo,hi};bf16x2_t b=__builtin_convertvector(v,bf16x2_t);return __builtin_bit_cast(unsigned,b);}
#define WAIT_BAR(N) asm volatile("s_waitcnt vmcnt(" #N ") lgkmcnt(0)\n\ts_barrier":::"memory")

__device__ __forceinline__ void qkt(f32x16&p0,f32x16&p1,const char*Kslot,const bf16x8*qr,int r32,int hi){
  const char*kb=Kslot+hi*1024+r32*16;
  #pragma unroll
  for(int d0=0;d0<4;++d0){
    const bf16x8 b0=*reinterpret_cast<const bf16x8*>(kb+d0*2048);
    const bf16x8 b1=*reinterpret_cast<const bf16x8*>(kb+d0*2048+512);
    p0=__builtin_amdgcn_mfma_f32_32x32x16_bf16(b0,qr[d0],p0,0,0,0);p1=__builtin_amdgcn_mfma_f32_32x32x16_bf16(b1,qr[d0],p1,0,0,0);}
}
typedef __attribute__((address_space(3))) const char* lds_cptr;
typedef short v4i16_t __attribute__((ext_vector_type(4)));
__device__ __forceinline__ void kload8(bf16x8*kf,lds_cptr kp){
  kf[0]=*(const __attribute__((address_space(3))) bf16x8*)(kp);      kf[1]=*(const __attribute__((address_space(3))) bf16x8*)(kp+512);
  kf[2]=*(const __attribute__((address_space(3))) bf16x8*)(kp+2048); kf[3]=*(const __attribute__((address_space(3))) bf16x8*)(kp+2560);
  kf[4]=*(const __attribute__((address_space(3))) bf16x8*)(kp+4096); kf[5]=*(const __attribute__((address_space(3))) bf16x8*)(kp+4608);
  kf[6]=*(const __attribute__((address_space(3))) bf16x8*)(kp+6144); kf[7]=*(const __attribute__((address_space(3))) bf16x8*)(kp+6656);
}
__device__ __forceinline__ void kload2(bf16x8*kf,lds_cptr kp,int j){ kf[2*j]=*(const __attribute__((address_space(3))) bf16x8*)(kp+j*2048); kf[2*j+1]=*(const __attribute__((address_space(3))) bf16x8*)(kp+j*2048+512); }
__device__ __forceinline__ s16x4 vtr(lds_cptr p){ return __builtin_bit_cast(s16x4,__builtin_amdgcn_ds_read_tr16_b64_v4i16((__attribute__((address_space(3))) v4i16_t*)p)); }
__device__ __forceinline__ float rowmax(const f32x16&p0,const f32x16&p1){
  float a=max3f(p0[0],p0[1],p1[0]),b=max3f(p0[2],p0[3],p1[1]);a=max3f(a,p1[2],p1[3]);
  #pragma unroll
  for(int r=4;r<16;r+=4){a=max3f(a,p0[r],p0[r+1]);b=max3f(b,p0[r+2],p0[r+3]);a=max3f(a,p1[r],p1[r+1]);b=max3f(b,p1[r+2],p1[r+3]);}
  const float m=max2f(a,b);
  auto rr=__builtin_amdgcn_permlane32_swap(__float_as_uint(m),__float_as_uint(m),false,false);
  return max2f(__uint_as_float(rr[0]),__uint_as_float(rr[1]));
}
__device__ __forceinline__ void pv(f32x16*o,int vb,bf16x8 pa0,bf16x8 pa1,bf16x8 pa2,bf16x8 pa3){
  #pragma unroll
  for(int d0=0;d0<2;++d0){s16x4 lo[4],hi[4];
    #pragma unroll
    for(int ks=0;ks<4;++ks){
      asm volatile("ds_read_b64_tr_b16 %0,%1 offset:%c2":"=&v"(lo[ks]):"v"(vb),"i"(d0*4096+ks*1024):"memory");
      asm volatile("ds_read_b64_tr_b16 %0,%1 offset:%c2":"=&v"(hi[ks]):"v"(vb),"i"(d0*4096+ks*1024+512):"memory");}
    asm volatile("s_waitcnt lgkmcnt(0)":::"memory");SBAR();
    #define PK(k) (bf16x8){lo[k][0],lo[k][1],lo[k][2],lo[k][3],hi[k][0],hi[k][1],hi[k][2],hi[k][3]}
    o[d0]=__builtin_amdgcn_mfma_f32_32x32x16_bf16(pa0,PK(0),o[d0],0,0,0);
    o[d0]=__builtin_amdgcn_mfma_f32_32x32x16_bf16(pa1,PK(1),o[d0],0,0,0);
    o[d0]=__builtin_amdgcn_mfma_f32_32x32x16_bf16(pa2,PK(2),o[d0],0,0,0);
    o[d0]=__builtin_amdgcn_mfma_f32_32x32x16_bf16(pa3,PK(3),o[d0],0,0,0);
    #undef PK
  }
}

typedef float f32x4v __attribute__((ext_vector_type(4)));
__device__ __forceinline__ u32x4 mul_bf16x8(u32x4 a,u32x4 z){u32x4 r;
  #pragma unroll
  for(int i=0;i<4;++i){const float al=__uint_as_float(a[i]<<16),ah=__uint_as_float(a[i]&0xffff0000u),zl=__uint_as_float(z[i]<<16),zh=__uint_as_float(z[i]&0xffff0000u);r[i]=cvtpk_s(al*zl,ah*zh);}
  return r;}
#ifndef ATTN_STORE16
#define ATTN_STORE16(p,v) (*(u32x4*)(p)=(v))
#endif
template<int THRL> __device__ __forceinline__ void attn_unit(int b,int h,int qb,const bf16*Q,const bf16*__restrict__ K,const bf16*__restrict__ V,bf16*O,const bf16*__restrict__ Z,const float*__restrict__ cumh,int t0,char*shm){
  int tid_=threadIdx.x; asm volatile("":"+v"(tid_)); const int tid=tid_,lane=tid&63,r32=lane&31,hi=lane>>5; const int wid=__builtin_amdgcn_readfirstlane(tid>>6);
  const long rowbase=(long)b*SEQ; const int q0=qb*QB;
  const bf16*Qw=Q+(rowbase+q0+wid*QBLK)*DM+h*D;
  const bf16*Kh=K+(rowbase+(long)t0*KVBLK)*DM+h*D,*Vh=V+(rowbase+(long)t0*KVBLK)*DM+h*D;
  const unsigned lds0=(unsigned)(uintptr_t)shm;
  float*wsf=(float*)(shm+LDS_WS)+wid*64;
  const bf16*ksrc=Kh+(long)lane*DM+wid*8;
  const bf16*vsrc=Vh+(long)(16*(wid&3)+(lane>>2))*DM+(wid>>2)*32+(lane&3)*8;
  const unsigned kdst=lds0+LDS_K+wid*1024, vdst=lds0+LDS_V+wid*1024;
  #define DMA_K(t,slot) glds16(ksrc+(long)(t)*KVBLK*DM,(unsigned)__builtin_amdgcn_readfirstlane(kdst+(slot)))
  #define DMA_V(t,slot) glds16(vsrc+(long)(t)*KVBLK*DM,(unsigned)__builtin_amdgcn_readfirstlane(vdst+(slot)))
  const int vb0=(int)(lds0+LDS_V)+((lane>>4)&1)*32+(lane&3)*8+(4*hi+((lane&15)>>2))*64;
  const char*Kbase=shm+LDS_K; bf16x8 kf[8];
  const lds_cptr shm3=(lds_cptr)shm; const lds_cptr kp0=shm3+LDS_K+hi*1024+r32*16; const lds_cptr vp0=shm3+LDS_V+((lane>>4)&1)*32+(lane&3)*8+(4*hi+((lane&15)>>2))*64;
  const int NT=(q0+QB)/KVBLK-t0;
  DMA_K(0,0);DMA_V(0,0);DMA_K(1,SLOTB);
  bf16x8 qr[4];
  #pragma unroll
  for(int d0=0;d0<4;++d0)qr[d0]=*reinterpret_cast<const bf16x8*>(&Qw[(long)r32*DM+d0*16+hi*8]);
  float mhat=0.f,l_reg=0.f;f32x16 o[2];o[0]=f32x16{};o[1]=f32x16{};
  const int qrel=wid*QBLK+r32;
  #define CMASK(P0,P1,t) do{int jb_=(t)-(NT-4); if(jb_>=0)cmask(P0,P1,jb_,qrel,hi);}while(0)
  bool resc=false;
  #define START(P0,P1) do{ const float rm=rowmax(P0,P1); resc=false; \
    { const float dl=rm; mhat=fadd_s(mhat,dl); \
      _Pragma("unroll") for(int r=0;r<16;++r){P0[r]=fsub_s(P0[r],dl);P1[r]=fsub_s(P1[r],dl);} \
      } \
    _Pragma("unroll") for(int r=0;r<16;++r)P0[r]=__builtin_amdgcn_exp2f(P0[r]); }while(0)
  #define RESC() do{ if(resc){ asm volatile("s_waitcnt lgkmcnt(0)":::"memory"); \
      _Pragma("unroll") for(int d_=0;d_<2;++d_) _Pragma("unroll") for(int r=0;r<16;++r)o[d_][r]*=wsf[crow(r,hi)]; } }while(0)
  f32x16 pA0,pA1,pB0,pB1;
  int sl_prev=0,sl_cur=0,sl_next=SLOTB;
  #define ROT() do{sl_prev=sl_cur;sl_cur=sl_next;sl_next=(sl_next==(NSLOT-1)*SLOTB)?0:sl_next+SLOTB;}while(0)
  DMA_K(2,2*SLOTB);
  typedef __attribute__((address_space(3))) float lds_f32; typedef __attribute__((address_space(3))) f32x4v lds_f32x4;
  lds_f32* const cb3=(lds_f32*)((__attribute__((address_space(3))) char*)shm+LDS_CB);
  { const float cref=cumh[q0]; const float*cs=cumh+t0*KVBLK; for(int i=tid;i<NT*KVBLK;i+=NW*64) cb3[i]=(cref-cs[i])*1.4426950408889634f; }
  #define CBLD(P0,P1,t) do{ const lds_f32x4* cp_=(const lds_f32x4*)(cb3+(t)*KVBLK+4*hi); \
    _Pragma("unroll") for(int g_=0;g_<4;++g_){ const f32x4v a_=cp_[2*g_], b_=cp_[8+2*g_]; \
      P0[4*g_]=a_[0]-mhat; P0[4*g_+1]=a_[1]-mhat; P0[4*g_+2]=a_[2]-mhat; P0[4*g_+3]=a_[3]-mhat; \
      P1[4*g_]=b_[0]-mhat; P1[4*g_+1]=b_[1]-mhat; P1[4*g_+2]=b_[2]-mhat; P1[4*g_+3]=b_[3]-mhat; } }while(0)
  WAIT_BAR(3);
  CBLD(pA0,pA1,0); qkt(pA0,pA1,Kbase,qr,r32,hi);asm volatile("s_nop 15\n\ts_nop 7":"+v"(pA0),"+v"(pA1));CMASK(pA0,pA1,0);
  START(pA0,pA1);
  _Pragma("unroll") for(int r=0;r<16;++r)pA1[r]=__builtin_amdgcn_exp2f(pA1[r]);
  WAIT_BAR(0);
  DMA_K(3,0);DMA_V(1,SLOTB);
  ROT();
  kload8(kf,kp0+sl_cur);
  WAIT_BAR(2);
  s16x4 vlo[8],vhi[8]; u32x4 pw0,pw1,pw2,pw3;
  #define PKW(P,B) cvtpk_s(P[B],P[B+1])
  #define PAF(k) __builtin_bit_cast(bf16x8,pw##k)
  #define VFR(i) (bf16x8){vlo[i][0],vlo[i][1],vlo[i][2],vlo[i][3],vhi[i][0],vhi[i][1],vhi[i][2],vhi[i][3]}
  #define PIN(x) asm volatile("":"+v"(x))
  #define MX3(a,b,c) __builtin_fmaxf(__builtin_fmaxf((a),(b)),(c))
  #define GAPA(MF,A0,A1,A2,A3,W0,W1,PW) do{ MF; sacc+=A0; sacc+=A1; sacc+=A2; sacc+=A3; PIN(sacc); W0; W1; PIN(PW); SBAR(); }while(0)
  #define EX(v) __builtin_amdgcn_exp2f(v)
  #define GAPB(MF,X,B) do{ MF; X[B]=EX(X[B]); X[B+1]=EX(X[B+1]); X[B+2]=EX(X[B+2]); X[B+3]=EX(X[B+3]); PIN(X); SBAR(); }while(0)
  #define VRD(i) do{ vlo[i]=vtr(vp_+(((i)>>2)*4096+((i)&3)*1024)); vhi[i]=vtr(vp_+(((i)>>2)*4096+((i)&3)*1024+512)); }while(0)
  #define KRD(G,j) do{ if(G){ kload2(kf,kp0+sl_next,j); SBAR(); } }while(0)
  #define STEP(C0,C1,P0,P1,t,GK,GV,GL) do{ SBAR(); \
    const lds_cptr vp_=vp0+sl_prev; \
    VRD(0); SBAR(); float sacc=(P0[0]+P0[1]); \
    GAPA(C0=__builtin_amdgcn_mfma_f32_32x32x16_bf16(kf[0],qr[0],C0,0,0,0), P0[2],P0[3],P0[4],P0[5],     pw0[0]=PKW(P0,0), pw0[1]=PKW(P0,2), pw0); \
    VRD(4); SBAR(); GAPA(C1=__builtin_amdgcn_mfma_f32_32x32x16_bf16(kf[1],qr[0],C1,0,0,0), P0[6],P0[7],P0[8],P0[9],     pw0[2]=PKW(P0,4), pw0[3]=PKW(P0,6), pw0); \
    VRD(1); SBAR(); GAPA(C0=__builtin_amdgcn_mfma_f32_32x32x16_bf16(kf[2],qr[1],C0,0,0,0),   P0[10],P0[11],P0[12],P0[13], pw1[0]=PKW(P0,8), pw1[1]=PKW(P0,10), pw1); \
    VRD(5); SBAR(); GAPA(C1=__builtin_amdgcn_mfma_f32_32x32x16_bf16(kf[3],qr[1],C1,0,0,0),   P0[14],P0[15],P1[0],P1[1],   pw1[2]=PKW(P0,12),pw1[3]=PKW(P0,14), pw1); \
    VRD(2); SBAR(); GAPA(C0=__builtin_amdgcn_mfma_f32_32x32x16_bf16(kf[4],qr[2],C0,0,0,0),   P1[2],P1[3],P1[4],P1[5],     pw2[0]=PKW(P1,0), pw2[1]=PKW(P1,2), pw2); \
    VRD(6); SBAR(); GAPA(C1=__builtin_amdgcn_mfma_f32_32x32x16_bf16(kf[5],qr[2],C1,0,0,0),   P1[6],P1[7],P1[8],P1[9],     pw2[2]=PKW(P1,4), pw2[3]=PKW(P1,6), pw2); \
    VRD(3); SBAR(); GAPA(C0=__builtin_amdgcn_mfma_f32_32x32x16_bf16(kf[6],qr[3],C0,0,0,0),   P1[10],P1[11],P1[12],P1[13], pw3[0]=PKW(P1,8), pw3[1]=PKW(P1,10), pw3); \
    VRD(7); SBAR(); GAPA(C1=__builtin_amdgcn_mfma_f32_32x32x16_bf16(kf[7],qr[3],C1,0,0,0),   P1[14],P1[15],0.f,0.f,       pw3[2]=PKW(P1,12),pw3[3]=PKW(P1,14), pw3); \
    l_reg+=sacc; \
    if(GK){DMA_K((t)+3,sl_cur);} if(GV){DMA_V((t)+1,sl_next);} \
    CMASK(C0,C1,t); \
    { float a=MX3(C0[0],C0[1],C1[0]),b=MX3(C0[2],C0[3],C1[1]); a=MX3(a,C1[2],C1[3]); \
      _Pragma("unroll") for(int r=4;r<16;r+=4){a=MX3(a,C0[r],C0[r+1]);b=MX3(b,C0[r+2],C0[r+3]);a=MX3(a,C1[r],C1[r+1]);b=MX3(b,C1[r+2],C1[r+3]);} \
      float rm=__builtin_fmaxf(a,b); { auto rr=__builtin_amdgcn_permlane32_swap(__float_as_uint(rm),__float_as_uint(rm),false,false); rm=__builtin_fmaxf(__uint_as_float(rr[0]),__uint_as_float(rr[1])); } \
      resc=false; \
      if(__builtin_expect(__any(rm>(float)THRL),0)){ const float dl=__builtin_fmaxf(rm,0.f); mhat+=dl; \
        _Pragma("unroll") for(int r=0;r<16;++r){C0[r]-=dl;C1[r]-=dl;} \
        const float f=__builtin_amdgcn_exp2f(-dl); l_reg*=f; if(hi==0)wsf[r32]=f; resc=true; } } \
    SBAR(); \
    GAPB(o[0]=__builtin_amdgcn_mfma_f32_32x32x16_bf16(PAF(0),VFR(0),o[0],0,0,0), C0,0); \
    GAPB(o[1]=__builtin_amdgcn_mfma_f32_32x32x16_bf16(PAF(0),VFR(4),o[1],0,0,0), C0,4); \
    KRD(GL,0); GAPB(o[0]=__builtin_amdgcn_mfma_f32_32x32x16_bf16(PAF(1),VFR(1),o[0],0,0,0), C0,8); \
    KRD(GL,1); GAPB(o[1]=__builtin_amdgcn_mfma_f32_32x32x16_bf16(PAF(1),VFR(5),o[1],0,0,0), C0,12); \
    KRD(GL,2); GAPB(o[0]=__builtin_amdgcn_mfma_f32_32x32x16_bf16(PAF(2),VFR(2),o[0],0,0,0), C1,0); \
    KRD(GL,3); GAPB(o[1]=__builtin_amdgcn_mfma_f32_32x32x16_bf16(PAF(2),VFR(6),o[1],0,0,0), C1,4); \
    GAPB(o[0]=__builtin_amdgcn_mfma_f32_32x32x16_bf16(PAF(3),VFR(3),o[0],0,0,0), C1,8); \
    GAPB(o[1]=__builtin_amdgcn_mfma_f32_32x32x16_bf16(PAF(3),VFR(7),o[1],0,0,0), C1,12); \
    if(GL){ CBLD(P0,P1,(t)+1); } \
    }while(0)
  CBLD(pB0,pB1,1);
  int t=1;
  #undef CMASK
  #define CMASK(P0,P1,t) do{}while(0)
  for(;t+5<NT;t+=2){
    STEP(pB0,pB1,pA0,pA1,t,true,true,true);     WAIT_BAR(2); RESC(); ROT();
    STEP(pA0,pA1,pB0,pB1,t+1,true,true,true);   WAIT_BAR(2); RESC(); ROT();
  }
  #undef CMASK
  #define CMASK(P0,P1,t) do{int jb_=(t)-(NT-4); if(jb_>=0)cmask(P0,P1,jb_,qrel,hi);}while(0)
  #define ENDW(tt) do{ if((tt)+3<NT){WAIT_BAR(2);} else if((tt)+2<NT){WAIT_BAR(1);} else {WAIT_BAR(0);} }while(0)
  for(;t+1<NT;t+=2){
    STEP(pB0,pB1,pA0,pA1,t,(t+3<NT),(t+1<NT),(t+1<NT));       ENDW(t);   RESC(); ROT();
    STEP(pA0,pA1,pB0,pB1,t+1,(t+4<NT),(t+2<NT),(t+2<NT));     ENDW(t+1); RESC(); ROT();
  }
  STEP(pB0,pB1,pA0,pA1,NT-1,false,false,false); RESC();
  { float sacc=pB0[0]+pB0[1]; _Pragma("unroll") for(int r=2;r<16;++r)sacc+=pB0[r]; _Pragma("unroll") for(int r=0;r<16;++r)sacc+=pB1[r]; l_reg+=sacc;
    pw0=(u32x4){PKW(pB0,0),PKW(pB0,2),PKW(pB0,4),PKW(pB0,6)};pw1=(u32x4){PKW(pB0,8),PKW(pB0,10),PKW(pB0,12),PKW(pB0,14)};pw2=(u32x4){PKW(pB1,0),PKW(pB1,2),PKW(pB1,4),PKW(pB1,6)};pw3=(u32x4){PKW(pB1,8),PKW(pB1,10),PKW(pB1,12),PKW(pB1,14)};
    SBAR(); pv(o,vb0+sl_cur,PAF(0),PAF(1),PAF(2),PAF(3)); }
  #undef PKW
  #undef PAF
  #undef VFR
  #undef PIN
  #undef MX3
  #undef GAPA
  #undef GAPB
  #undef EX
  #undef VRD
  #undef KRD
  #undef STEP
  #undef ENDW
  {auto rr=__builtin_amdgcn_permlane32_swap(__float_as_uint(l_reg),__float_as_uint(l_reg),false,false);l_reg=__uint_as_float(rr[0])+__uint_as_float(rr[1]);}
  if(hi==0)wsf[32+r32]=l_reg;asm volatile("s_waitcnt lgkmcnt(0)":::"memory");
  float rli[16];
  #pragma unroll
  for(int r=0;r<16;++r)rli[r]=__builtin_amdgcn_rcpf(wsf[32+crow(r,hi)]);
  bf16*Ow=O+(rowbase+q0+wid*QBLK)*DM+h*D; const bf16*Zw=Z+(rowbase+q0+wid*QBLK)*DM+h*D;
  { bf16*stg=(bf16*)(shm+LDS_OST)+wid*2048;
    #pragma unroll
    for(int r=0;r<16;++r){const int orow=crow(r,hi);
      #pragma unroll
      for(int d0=0;d0<2;++d0)stg[orow*64+d0*32+r32]=__float2bfloat16(o[d0][r]*rli[r]);}
    asm volatile("s_waitcnt lgkmcnt(0)":::"memory");
    #pragma unroll
    for(int i=0;i<4;++i){const int row=i*8+(lane>>3),ch=lane&7; const u32x4 v=*(const u32x4*)(stg+row*64+ch*8); const u32x4 zz=*(const u32x4*)(Zw+(long)row*DM+ch*8); ATTN_STORE16(Ow+(long)row*DM+ch*8,mul_bf16x8(v,zz));} }
  asm volatile("s_waitcnt lgkmcnt(0)\n\ts_barrier":::"memory");
  #undef CBLD
  #undef DMA_K
  #undef DMA_V
  #undef CMASK
  #undef START
  #undef RESC
  #undef ROT
}
constexpr int ATTN_LDS_BYTES=LDS_BYTES;
__device__ __forceinline__ void swa_unit(int b,int kvh,int blk,bf16*PJ,const float*__restrict__ sinks,char*shm){
  int tid_=threadIdx.x; asm volatile("":"+v"(tid_)); const int tid=tid_,lane=tid&63,r32=lane&31,hi=lane>>5; const int wid=__builtin_amdgcn_readfirstlane(tid>>6);
  const long rowbase=(long)b*SEQ; const int q0=blk*64,kb0=q0-128;
  const int hq=4*kvh+(wid>>1),r0=q0+32*(wid&1);
  const unsigned lds0=(unsigned)(uintptr_t)shm;
  float*wsf=(float*)(shm+LDS_WS)+wid*64;
  const bf16*Kh=PJ+rowbase*DM+512+kvh*D,*Vh=PJ+rowbase*DM+640+kvh*D;
  #pragma unroll
  for(int j=0;j<3;++j){
    int kr=kb0+64*j+lane; kr=kr<0?0:kr;
    glds16(Kh+(long)kr*DM+wid*8,(unsigned)__builtin_amdgcn_readfirstlane(lds0+LDS_K+j*SLOTB+wid*1024));
    int vr=kb0+64*j+16*(wid&3)+(lane>>2); vr=vr<0?0:vr;
    glds16(Vh+(long)vr*DM+(wid>>2)*32+(lane&3)*8,(unsigned)__builtin_amdgcn_readfirstlane(lds0+LDS_V+j*SLOTB+wid*1024));
  }
  const bf16*Qw=PJ+(rowbase+r0)*DM+hq*D;
  bf16x8 qr[4];
  #pragma unroll
  for(int d0=0;d0<4;++d0)qr[d0]=*reinterpret_cast<const bf16x8*>(&Qw[(long)r32*DM+d0*16+hi*8]);
  const float sk=sinks[hq]*1.4426950408889634f;
  WAIT_BAR(0);
  f32x16 p[3][2];
  #pragma unroll
  for(int j=0;j<3;++j){p[j][0]=f32x16{};p[j][1]=f32x16{};qkt(p[j][0],p[j][1],shm+LDS_K+j*SLOTB,qr,r32,hi);}
  const int q=r0+r32; float m=-INFINITY;
  #pragma unroll
  for(int j=0;j<3;++j)
    #pragma unroll
    for(int hf=0;hf<2;++hf)
      #pragma unroll
      for(int r=0;r<16;++r){const int kv=kb0+64*j+32*hf+crow(r,hi); const bool ok=(kv>=0)&&(kv<=q)&&(q-kv<128); const float v=ok?p[j][hf][r]:-INFINITY; p[j][hf][r]=v; m=__builtin_fmaxf(m,v);}
  {auto rr=__builtin_amdgcn_permlane32_swap(__float_as_uint(m),__float_as_uint(m),false,false); m=__builtin_fmaxf(__uint_as_float(rr[0]),__uint_as_float(rr[1]));}
  m=__builtin_fmaxf(m,sk);
  float l=0.f;
  #pragma unroll
  for(int j=0;j<3;++j)
    #pragma unroll
    for(int hf=0;hf<2;++hf)
      #pragma unroll
      for(int r=0;r<16;++r){const float e=__builtin_amdgcn_exp2f(p[j][hf][r]-m); p[j][hf][r]=e; l+=e;}
  {auto rr=__builtin_amdgcn_permlane32_swap(__float_as_uint(l),__float_as_uint(l),false,false); l=__uint_as_float(rr[0])+__uint_as_float(rr[1]);}
  l+=__builtin_amdgcn_exp2f(sk-m);
  f32x16 o[2]; o[0]=f32x16{}; o[1]=f32x16{};
  const int vb0=(int)(lds0+LDS_V)+((lane>>4)&1)*32+(lane&3)*8+(4*hi+((lane&15)>>2))*64;
  #pragma unroll
  for(int j=0;j<3;++j){
    #define PKW(P,B) cvtpk_s(P[B],P[B+1])
    const u32x4 pw0=(u32x4){PKW(p[j][0],0),PKW(p[j][0],2),PKW(p[j][0],4),PKW(p[j][0],6)},pw1=(u32x4){PKW(p[j][0],8),PKW(p[j][0],10),PKW(p[j][0],12),PKW(p[j][0],14)};
    const u32x4 pw2=(u32x4){PKW(p[j][1],0),PKW(p[j][1],2),PKW(p[j][1],4),PKW(p[j][1],6)},pw3=(u32x4){PKW(p[j][1],8),PKW(p[j][1],10),PKW(p[j][1],12),PKW(p[j][1],14)};
    #undef PKW
    SBAR(); pv(o,vb0+j*SLOTB,__builtin_bit_cast(bf16x8,pw0),__builtin_bit_cast(bf16x8,pw1),__builtin_bit_cast(bf16x8,pw2),__builtin_bit_cast(bf16x8,pw3));
  }
  if(hi==0)wsf[32+r32]=l; asm volatile("s_waitcnt lgkmcnt(0)":::"memory");
  float rli[16];
  #pragma unroll
  for(int r=0;r<16;++r)rli[r]=__builtin_amdgcn_rcpf(wsf[32+crow(r,hi)]);
  bf16*Ow=PJ+(rowbase+r0)*DM+hq*D; const bf16*Zw=PJ+(rowbase+r0)*DM+768+hq*D;
  { bf16*stg=(bf16*)(shm+LDS_OST)+wid*2048;
    #pragma unroll
    for(int r=0;r<16;++r){const int orow=crow(r,hi);
      #pragma unroll
      for(int d0=0;d0<2;++d0)stg[orow*64+d0*32+r32]=__float2bfloat16(o[d0][r]*rli[r]);}
    asm volatile("s_waitcnt lgkmcnt(0)":::"memory");
    #pragma unroll
    for(int i=0;i<4;++i){const int row=i*8+(lane>>3),ch=lane&7; const u32x4 v=*(const u32x4*)(stg+row*64+ch*8); const u32x4 zz=*(const u32x4*)(Zw+(long)row*DM+ch*8); *(u32x4*)(Ow+(long)row*DM+ch*8)=mul_bf16x8(v,zz);} }
  asm volatile("s_waitcnt lgkmcnt(0)\n\ts_barrier":::"memory");
}
template<int THRL=8> __device__ __forceinline__ void fox_phase(char*lds,bf16*PJ,const float*__restrict__ CUM,int vcu,int G){
  for(int L=vcu;L<1024;L+=G){ const int vc=L&255,i=L>>8,s=vc&7,bh=vc>>3; const int qb=(i==0)?s:(i==1)?15-s:(i==2)?16+s:31-s;
    attn_unit<THRL>(bh/NHEAD,bh%NHEAD,qb,PJ+1280,PJ+1792,PJ+2304,PJ+1280,PJ+2816,CUM+(long)bh*SEQ,0,lds); }
}
__device__ __forceinline__ void swa_phase(char*lds,bf16*PJ,const float*__restrict__ sinks,int vcu,int G){
  for(int L=vcu;L<1024;L+=G){ const int blk=L&127,kvh=(L>>7)&1,b=L>>8; swa_unit(b,kvh,blk,PJ,sinks,lds); }
}
#undef SBAR
#undef WAIT_BAR
}

constexpr int NWAVES = 8;
constexpr int BATCH = 4, SEQ = 8192, DM_ = 1024, M = BATCH * SEQ, INW = 5384, PJW = pg8::PJW;
constexpr float NORM_EPS = 1e-6f;
constexpr size_t MiB = 1u << 20;
constexpr size_t WS_W1T = 2 * MiB;
constexpr size_t WS_WAT = 14 * MiB;
constexpr size_t WS_WBT = 15 * MiB;
constexpr size_t WS_WOT = 16 * MiB;
constexpr size_t WS_ADAP = 18 * MiB;
constexpr size_t WS_GATE = 19 * MiB;
constexpr size_t WS_LC = 20 * MiB;
constexpr size_t WS_CT = 21 * MiB;
constexpr size_t WS_CUM = 22 * MiB;
constexpr size_t WS_ROPE = 24 * MiB;
constexpr size_t WS_RSS = 32 * MiB;
constexpr size_t WS_H = 64 * MiB;
constexpr size_t WS_PJ = 128 * MiB;
constexpr size_t WS_END = WS_PJ + (size_t)M * PJW * 2;
constexpr int LDS_BYTES = 147456;
static_assert(attn_body::ATTN_LDS_BYTES <= 131072 && pg8::STAGE_BYTES <= 131072, "LDS");

#define LAS __attribute__((address_space(3)))
typedef unsigned short bf16;
typedef unsigned v4u __attribute__((ext_vector_type(4)));
typedef float f32x4 __attribute__((ext_vector_type(4)));
#define LDS_WAIT() asm volatile("s_waitcnt lgkmcnt(0)" ::: "memory")
__device__ __forceinline__ unsigned f2bf(float f) { unsigned u = __builtin_bit_cast(unsigned, f); return (u + 0x7fffu + ((u >> 16) & 1u)) >> 16; }
__device__ __forceinline__ unsigned pk2(float lo, float hi) { return f2bf(lo) | (f2bf(hi) << 16); }
__device__ __forceinline__ float wave_sum(float v) {
#pragma unroll
    for (int o = 1; o < 64; o <<= 1) v += __shfl_xor(v, o);
    return v;
}
__device__ __forceinline__ int w1_src_col(int n) {
    if (n >= 2816) return n + 8;
    if (n < 640) { const int hb = n & ~63, p = n & 63; return hb + 16 * (p >> 5) + 4 * ((p >> 3) & 3) + (p & 3) + 32 * ((p >> 2) & 1); }
    return n;
}
template <bool MAP> __device__ __forceinline__ void p0_transpose_item(const float* W, int K, int Nsrc, int Nout, bf16* WT, LAS float* scr, int item, int lane) {
    const int nblk = Nout / 32, kb = item / nblk, nb = item % nblk, k0 = 64 * kb, n0 = 32 * nb;
    const int sc = MAP ? w1_src_col(n0 + (lane & 31)) : n0 + (lane & 31);
#pragma unroll 8
    for (int i = 0; i < 32; ++i) { const int kk = 2 * i + (lane >> 5); scr[kk * 33 + (lane & 31)] = W[(size_t)(k0 + kk) * Nsrc + sc]; }
    LDS_WAIT(); asm volatile("" ::: "memory");
    const int c = lane & 7;
#pragma unroll
    for (int j = 0; j < 4; ++j) { const int n = (lane >> 3) + 8 * j; const LAS float* s = scr + (8 * c) * 33 + n;
        v4u o; o.x = pk2(s[0 * 33], s[1 * 33]); o.y = pk2(s[2 * 33], s[3 * 33]); o.z = pk2(s[4 * 33], s[5 * 33]); o.w = pk2(s[6 * 33], s[7 * 33]);
        *(v4u*)(WT + (size_t)(n0 + n) * K + k0 + 8 * c) = o; }
    LDS_WAIT(); asm volatile("" ::: "memory");
}

struct Args { const float *x, *c; const int* pos; const float *w_ada, *b_ada, *g_norm, *w_in, *b_f, *sinks, *w_o_swa, *w_o_fox, *w_out, *g_final; float* out; unsigned char* ws; };

__global__ void __launch_bounds__(NWAVES * 64, 2) mk_fwd(Args a) {
    extern __shared__ __attribute__((aligned(16))) unsigned char lds[];
    cg::grid_group grid = cg::this_grid();
    LAS unsigned char* ldsl = (LAS unsigned char*)lds;
    const int G = gridDim.x; const int bx = blockIdx.x; const int vcu = (G % 8 == 0) ? (bx % 8) * (G / 8) + bx / 8 : bx;
    unsigned char* ws = a.ws;
    bf16* W1T = (bf16*)(ws + WS_W1T); bf16* WAT = (bf16*)(ws + WS_WAT); bf16* WBT = (bf16*)(ws + WS_WBT); bf16* WOT = (bf16*)(ws + WS_WOT);
    float* ADAP = (float*)(ws + WS_ADAP); float* GATE = (float*)(ws + WS_GATE); float* LC = (float*)(ws + WS_LC); float* CT = (float*)(ws + WS_CT);
    float* CUM = (float*)(ws + WS_CUM); float* ROPE = (float*)(ws + WS_ROPE); float* RSS = (float*)(ws + WS_RSS);
    bf16* H = (bf16*)(ws + WS_H); bf16* MG = (bf16*)(ws + WS_H); bf16* PJ = (bf16*)(ws + WS_PJ);

    {
        int t_ = threadIdx.x; asm volatile("" : "+v"(t_)); const int tid = t_, lane = tid & 63, wave = __builtin_amdgcn_readfirstlane(tid >> 6); (void)tid; (void)lane; (void)wave;
        LAS float* scr = (LAS float*)(ldsl + wave * 16384);
        const int gw = vcu * NWAVES + wave, NGW = G * NWAVES;
        constexpr int I_1 = (1024 / 64) * (PJW / 32), I_A = (512 / 64) * (1024 / 32), I_O = (1024 / 64) * (1024 / 32), I_ADA = 48 * 8;
        for (int it = gw; it < I_1 + 2 * I_A + I_O + I_ADA; it += NGW) {
            int r = it;
            if (r < I_1) { p0_transpose_item<true>(a.w_in, 1024, INW, PJW, W1T, scr, r, lane); continue; } r -= I_1;
            if (r < I_A) { p0_transpose_item<false>(a.w_o_swa, 512, 1024, 1024, WAT, scr, r, lane); continue; } r -= I_A;
            if (r < I_A) { p0_transpose_item<false>(a.w_o_fox, 512, 1024, 1024, WBT, scr, r, lane); continue; } r -= I_A;
            if (r < I_O) { p0_transpose_item<false>(a.w_out, 1024, 1024, 1024, WOT, scr, r, lane); continue; } r -= I_O;
            { const int cc = r % 48, ks = r / 48, col = cc * 64 + lane; float s0 = 0.f, s1 = 0.f, s2 = 0.f, s3 = 0.f;
              for (int k = ks * 128; k < ks * 128 + 128; ++k) { const float w = a.w_ada[(size_t)k * 3072 + col]; s0 += a.c[k] * w; s1 += a.c[1024 + k] * w; s2 += a.c[2048 + k] * w; s3 += a.c[3072 + k] * w; }
              float* o = ADAP + (size_t)ks * 4 * 3072 + col; o[0] = s0; o[3072] = s1; o[2 * 3072] = s2; o[3 * 3072] = s3; }
        }
    }
    grid.sync();

    {
        int t_ = threadIdx.x; asm volatile("" : "+v"(t_)); const int tid = t_, lane = tid & 63, wave = __builtin_amdgcn_readfirstlane(tid >> 6); (void)tid; (void)lane; (void)wave;
        LAS float* gsL = (LAS float*)ldsl; LAS float* shL = gsL + 1024;
        for (int rb = bx; rb < M / 128; rb += G) {
            const int b = rb / 64;
            for (int c = tid; c < 2048; c += NWAVES * 64) { float v = a.b_ada[c];
#pragma unroll
                for (int ks = 0; ks < 8; ++ks) v += ADAP[(size_t)(ks * 4 + b) * 3072 + c];
                if (c < 1024) shL[c] = v; else gsL[c - 1024] = a.g_norm[c - 1024] * (1.0f + v); }
            if ((rb & 63) == 0) for (int c = tid; c < 1024; c += NWAVES * 64) { float v = a.b_ada[2048 + c];
#pragma unroll
                for (int ks = 0; ks < 8; ++ks) v += ADAP[(size_t)(ks * 4 + b) * 3072 + 2048 + c];
                GATE[b * 1024 + c] = v; }
            __syncthreads();
            f32x4 gs[4], sh[4];
#pragma unroll
            for (int j = 0; j < 4; ++j) { gs[j] = *(const LAS f32x4*)(gsL + 256 * j + 4 * lane); sh[j] = *(const LAS f32x4*)(shL + 256 * j + 4 * lane); }
            float run[8];
#pragma unroll
            for (int hh = 0; hh < 8; ++hh) run[hh] = 0.f;
            const float invf = __builtin_powf(10000.0f, -(float)(lane & 31) * (1.0f / 32.0f));
            float bfv[8];
#pragma unroll
            for (int hh = 0; hh < 8; ++hh) bfv[hh] = a.b_f[hh];
            for (int i = 0; i < 16; ++i) {
                const int row = rb * 128 + wave * 16 + i;
                const f32x4* xr = (const f32x4*)(a.x + (size_t)row * 1024) + lane;
                f32x4 v[4]; float s = 0.f;
#pragma unroll
                for (int j = 0; j < 4; ++j) { v[j] = xr[64 * j]; s += (v[j][0] * v[j][0] + v[j][1] * v[j][1]) + (v[j][2] * v[j][2] + v[j][3] * v[j][3]); }
                const float rs = 1.0f / sqrtf(wave_sum(s) * (1.0f / 1024.0f) + NORM_EPS);
                unsigned long long* o8 = (unsigned long long*)(H + (size_t)row * 1024) + lane;
                float f[8];
#pragma unroll
                for (int hh = 0; hh < 8; ++hh) f[hh] = 0.f;
#pragma unroll
                for (int j = 0; j < 4; ++j) { v[j] = v[j] * rs * gs[j] + sh[j];
                    o8[64 * j] = (unsigned long long)pk2(v[j][0], v[j][1]) | ((unsigned long long)pk2(v[j][2], v[j][3]) << 32);
#pragma unroll
                    for (int e = 0; e < 4; ++e) { const f32x4* wp = (const f32x4*)(a.w_in + (size_t)(256 * j + 4 * lane + e) * INW + 2816); const f32x4 w0 = wp[0], w1 = wp[1];
                        f[0] += v[j][e] * w0[0]; f[1] += v[j][e] * w0[1]; f[2] += v[j][e] * w0[2]; f[3] += v[j][e] * w0[3]; f[4] += v[j][e] * w1[0]; f[5] += v[j][e] * w1[1]; f[6] += v[j][e] * w1[2]; f[7] += v[j][e] * w1[3]; } }
#pragma unroll
                for (int hh = 0; hh < 8; ++hh) { const float z = wave_sum(f[hh]) + bfv[hh]; const float lf = fminf(z, 0.f) - log1pf(expf(-fabsf(z))); run[hh] += lf; }
                float sel = run[0];
#pragma unroll
                for (int hh = 1; hh < 8; ++hh) sel = (lane == hh) ? run[hh] : sel;
                if (lane < 8) LC[(size_t)row * 8 + lane] = sel;
                if (i == 15 && lane < 8) CT[(size_t)(row >> 4) * 8 + lane] = sel;
                if (lane < 32) { const float ang = (float)a.pos[row] * invf; const float kq = rintf(ang * 0.15915494309189535f);
                    float r = fmaf(-kq, 6.2831854820251465f, ang); r = fmaf(-kq, -1.7484555314695172e-07f, r);
                    typedef float f32x2 __attribute__((ext_vector_type(2)));
                    *((f32x2*)(ROPE + (size_t)row * 64) + lane) = (f32x2){__cosf(r), __sinf(r)}; }
            }
            __syncthreads();
        }
    }
    grid.sync();

    {
        int t_ = threadIdx.x; asm volatile("" : "+v"(t_)); const int tid = t_, lane = tid & 63, wave = __builtin_amdgcn_readfirstlane(tid >> 6); (void)tid; (void)lane; (void)wave;
        LAS float* red = (LAS float*)ldsl;
        for (int rb = bx; rb < M / 128; rb += G) {
            const int b = rb / 64, c0 = rb * 8, npc = c0 - b * 512;
            float pv8[8];
            { f32x4 p0 = (f32x4){0.f, 0.f, 0.f, 0.f}, p1 = p0; if (tid < npc) { const f32x4* cp = (const f32x4*)(CT + (size_t)(b * 512 + tid) * 8); p0 = cp[0]; p1 = cp[1]; }
              pv8[0] = p0[0]; pv8[1] = p0[1]; pv8[2] = p0[2]; pv8[3] = p0[3]; pv8[4] = p1[0]; pv8[5] = p1[1]; pv8[6] = p1[2]; pv8[7] = p1[3]; }
            __syncthreads();
#pragma unroll
            for (int hh = 0; hh < 8; ++hh) { const float s = wave_sum(pv8[hh]); if (lane == 0) red[wave * 8 + hh] = s; }
            __syncthreads();
            { const int r = tid >> 2, h0 = 2 * (tid & 3), row = rb * 128 + r, cc = r >> 4;
#pragma unroll
              for (int e = 0; e < 2; ++e) { const int hh = h0 + e; float base = 0.f;
#pragma unroll
                  for (int w = 0; w < 8; ++w) base += red[w * 8 + hh];
                  for (int c = 0; c < cc; ++c) base += CT[(size_t)(c0 + c) * 8 + hh];
                  CUM[(size_t)(b * 8 + hh) * SEQ + (row - b * SEQ)] = base + LC[(size_t)row * 8 + hh]; } }
            __syncthreads();
        }
        pg8::Gemm g{H, W1T, H, W1T, 1024, M, PJW, 1024}; pg8::StaticOrder S; S.init(M, PJW, G, bx, 1);
        pg8::EpiProj E{PJ, ROPE};
        pg8::gemm_phase<pg8::EpiProj, pg8::StaticOrder, true, true>(ldsl, g, S, E);
    }
    grid.sync();

    attn_body::swa_phase((char*)lds, (attn_body::bf16*)PJ, a.sinks, vcu, G);
    attn_body::fox_phase<8>((char*)lds, (attn_body::bf16*)PJ, CUM, vcu, G);
    grid.sync();

    {
        pg8::Gemm g{PJ, WAT, PJ + 1280, WBT, PJW, M, 1024, 512}; pg8::StaticOrder S; S.init(M, 1024, G, bx, 2);
        pg8::EpiMerge E{PJ, MG};
        pg8::gemm_phase<pg8::EpiMerge, pg8::StaticOrder, true, true>(ldsl, g, S, E);
    }
    grid.sync();

    {
        pg8::Gemm g{MG, WOT, MG, WOT, 1024, M, 1024, 1024}; pg8::StaticOrder S; S.init(M, 1024, G, bx, 1);
        pg8::EpiOut E{a.x, GATE, a.out, RSS};
        pg8::gemm_phase<pg8::EpiOut, pg8::StaticOrder, true, true>(ldsl, g, S, E);
    }
    grid.sync();

    {
        int t_ = threadIdx.x; asm volatile("" : "+v"(t_)); const int tid = t_, lane = tid & 63, wave = __builtin_amdgcn_readfirstlane(tid >> 6); (void)tid; (void)lane; (void)wave;
        const int gw = bx * NWAVES + wave, NGW = G * NWAVES;
        f32x4 gf[4];
#pragma unroll
        for (int j = 0; j < 4; ++j) gf[j] = *((const f32x4*)a.g_final + 64 * j + lane);
        for (int row = gw; row < M; row += NGW) {
            float s = RSS[(size_t)row * 16 + (lane & 15)];
            s += __shfl_xor(s, 1); s += __shfl_xor(s, 2); s += __shfl_xor(s, 4); s += __shfl_xor(s, 8);
            const float rs = 1.0f / sqrtf(s * (1.0f / 1024.0f) + NORM_EPS);
            f32x4* o = (f32x4*)(a.out + (size_t)row * 1024) + lane;
#pragma unroll
            for (int j = 0; j < 4; ++j) o[64 * j] = o[64 * j] * rs * gf[j];
        }
    }
}

extern "C" void kernel_launch(void* const* d_in, const int* in_sizes, int n_in, void* d_out, int out_size, void* d_ws, size_t ws_size, hipStream_t stream) {
    static int grid = 0;
    if (grid == 0) {
        if (n_in != 13 || out_size != M * 1024 || ws_size < WS_END) { fprintf(stderr, "kernel_launch: unexpected problem (n_in %d, out %d, ws %zu)\n", n_in, out_size, ws_size); grid = -1; return; }
        int dev = 0, cus = 0, per_cu = 0;
        (void)hipGetDevice(&dev);
        (void)hipDeviceGetAttribute(&cus, hipDeviceAttributeMultiprocessorCount, dev);
        (void)hipFuncSetAttribute((const void*)mk_fwd, hipFuncAttributeMaxDynamicSharedMemorySize, LDS_BYTES);
        (void)hipOccupancyMaxActiveBlocksPerMultiprocessor(&per_cu, (const void*)mk_fwd, NWAVES * 64, LDS_BYTES);
        if (per_cu < 1) { fprintf(stderr, "kernel_launch: occupancy query reports %d\n", per_cu); grid = -1; return; }
        grid = cus;
    }
    if (grid < 0) return;
    Args a{};
    a.x = (const float*)d_in[0]; a.c = (const float*)d_in[1]; a.pos = (const int*)d_in[2]; a.w_ada = (const float*)d_in[3]; a.b_ada = (const float*)d_in[4]; a.g_norm = (const float*)d_in[5];
    a.w_in = (const float*)d_in[6]; a.b_f = (const float*)d_in[7]; a.sinks = (const float*)d_in[8]; a.w_o_swa = (const float*)d_in[9]; a.w_o_fox = (const float*)d_in[10]; a.w_out = (const float*)d_in[11];
    a.g_final = (const float*)d_in[12]; a.out = (float*)d_out; a.ws = (unsigned char*)d_ws;
    void* args[] = {&a};
    hipError_t e = hipLaunchCooperativeKernel((void*)mk_fwd, dim3(grid), dim3(NWAVES * 64), args, LDS_BYTES, stream);
    if (e != hipSuccess) fprintf(stderr, "kernel_launch: cooperative launch failed: %s (grid %d)\n", hipGetErrorString(e), grid);
}
```

```cpp
#include <hip/hip_runtime.h>
#include <hip/hip_cooperative_groups.h>
#include <cstdio>
#include <cstdint>
namespace cg = cooperative_groups;
#define PROBE_P2 0
#define PROBE_SWA 0
#define PROBE_FOX 0
#define PROBE_P4 0
#define PROBE_P5 0
#define PROBE_P0 0
#define PROBE_P1 0
#define PROBE_SYNC 0
__device__ __forceinline__ int opaque_i(int v) { asm volatile("" : "+s"(v)); return v; }
namespace pg8 {
#define PG8_LAS __attribute__((address_space(3)))
typedef unsigned short bf16_t;
typedef short bf16x8 __attribute__((ext_vector_type(8)));
typedef float f32x4 __attribute__((ext_vector_type(4)));
typedef unsigned u32x4 __attribute__((ext_vector_type(4)));
typedef unsigned u32x2 __attribute__((ext_vector_type(2)));
constexpr int BM = 256, BK = 64, HALF = 128, HTB = HALF * BK * 2  , STAGE_BYTES = 8 * HTB, NXCD = 8, WGM = 8;

__host__ __device__ __forceinline__ int lds_byte(int r, int c) { const int st = (r >> 4) * 2 + (c >> 5), rr = r & 15, cc = c & 31, ob = rr * 64 + cc * 2; return st * 1024 + (ob ^ (((ob >> 9) & 1) << 5)); }
__host__ __device__ __forceinline__ void stage_rc(int b, int& R, int& C) { const int st = b / 1024, sb = b % 1024, swz = sb ^ (((sb >> 9) & 1) << 5); R = (st >> 1) * 16 + swz / 64; C = (st & 1) * 32 + (swz % 64) / 2; }
__host__ __device__ __forceinline__ int perm32(int rho) { const int n = rho >> 4, i = rho & 15; return 8 * (i >> 2) + 4 * n + (i & 3); }

struct Unit { int pm, pn, z; };
struct Gemm { const bf16_t* A; const bf16_t* Bt; const bf16_t* A2; const bf16_t* Bt2; int lda, M, N, K; };

struct StaticOrder {
    int nM, nN, nwg, G, c, nz;
    __host__ __device__ void init(int M, int N, int G_, int c_, int nz_) { nM = M / BM; nN = N / BM; nwg = nM * nN; G = G_; c = c_; nz = nz_; }
    __host__ __device__ bool next(int i, Unit& u) const {
        const int it = (nz == 2) ? (i >> 1) : i; u.z = (nz == 2) ? (i & 1) : 0;
        const long L = (long)it * G + c; if (L >= nwg) return false;
        int wgid = (int)L; { const int q = nwg / NXCD, r = nwg % NXCD, xcd = wgid % NXCD, off = wgid / NXCD; wgid = (xcd < r ? xcd * (q + 1) : r * (q + 1) + (xcd - r) * q) + off; }
        const int nig = WGM * nN, gid = wgid / nig, fm = gid * WGM, gsz = (nM - fm) < WGM ? (nM - fm) : WGM;
        u.pm = fm + ((wgid % nig) % gsz); u.pn = (wgid % nig) / gsz; return true;
    }
    __device__ __forceinline__ void a_ready(const Unit&) const {}
    __device__ __forceinline__ void done(const Unit&) const {}
};

__device__ __forceinline__ unsigned cvt_pk_bf16(float lo, float hi) { unsigned r; asm volatile("v_cvt_pk_bf16_f32 %0, %1, %2" : "=v"(r) : "v"(lo), "v"(hi)); return r; }
__device__ __forceinline__ float bf_lo(unsigned u) { return __uint_as_float(u << 16); }
__device__ __forceinline__ float bf_hi(unsigned u) { return __uint_as_float(u & 0xffff0000u); }
__device__ __forceinline__ float sigmoidf_(float v) { return __builtin_amdgcn_rcpf(1.0f + __builtin_amdgcn_exp2f(-1.4426950408889634f * v)); }

constexpr int PJW = 5376;
constexpr float QC2 = 0.125f * 1.4426950408889634f;
struct EpiProj {
    static constexpr bool PERM = true, AFTER_DRAIN = false;
    bf16_t* O; const float* rope; unsigned* kmax2; unsigned* qmax2;
    __device__ __forceinline__ void operator()(const f32x4 (&acc)[2][2][4][2], const Unit& u, int wr, int wc, int fr, int fq) const {
        const int row0 = u.pm * BM + wr * 64 + fr;
#pragma unroll
        for (int bj = 0; bj < 2; ++bj) {
            const int hx = 2 * u.pn + bj;
            if (hx < 5) {
                const float sc = hx < 4 ? QC2 : 1.0f; const int d0 = 16 * (wc & 1) + 4 * fq; const int colb = hx * HALF + 64 * (wc >> 1) + d0;
#pragma unroll
                for (int ai = 0; ai < 2; ++ai)
#pragma unroll
                    for (int m = 0; m < 4; ++m) { const int row = row0 + ai * HALF + m * 16; const f32x4* rp = (const f32x4*)(rope + (size_t)row * 64 + 2 * d0);
                        const f32x4 cs0 = rp[0], cs1 = rp[1]; const f32x4 v0 = acc[ai][bj][m][0], v1 = acc[ai][bj][m][1];
                        const float c0 = cs0[0], s0 = cs0[1], c1 = cs0[2], s1 = cs0[3], c2 = cs1[0], s2 = cs1[1], c3 = cs1[2], s3 = cs1[3];
                        u32x2 lo, hi;
                        lo.x = cvt_pk_bf16((v0[0] * c0 - v1[0] * s0) * sc, (v0[1] * c1 - v1[1] * s1) * sc); lo.y = cvt_pk_bf16((v0[2] * c2 - v1[2] * s2) * sc, (v0[3] * c3 - v1[3] * s3) * sc);
                        hi.x = cvt_pk_bf16((v1[0] * c0 + v0[0] * s0) * sc, (v1[1] * c1 + v0[1] * s1) * sc); hi.y = cvt_pk_bf16((v1[2] * c2 + v0[2] * s2) * sc, (v1[3] * c3 + v0[3] * s3) * sc);
                        bf16_t* rowp = O + (size_t)row * PJW + colb; *(u32x2*)rowp = lo; *(u32x2*)(rowp + 32) = hi; }
            } else {
                const int op = (hx == 5 || (hx >= 14 && hx < 22)) ? 0 : (hx >= 10 && hx < 14) ? 1 : (hx < 26) ? 2 : 3;
                const int col0 = hx * HALF + wc * 32 + 8 * fq; const bool nrm = hx >= 10 && hx < 18; float nmx = 0.f;
#pragma unroll
                for (int ai = 0; ai < 2; ++ai)
#pragma unroll
                    for (int m = 0; m < 4; ++m) { const int row = row0 + ai * HALF + m * 16; f32x4 v0 = acc[ai][bj][m][0], v1 = acc[ai][bj][m][1];
                        if (op == 1) { v0 = v0 * QC2; v1 = v1 * QC2; }
                        else if (op >= 2) {
#pragma unroll
                            for (int e = 0; e < 4; ++e) { const float s0 = sigmoidf_(v0[e]), s1 = sigmoidf_(v1[e]); v0[e] = op == 2 ? v0[e] * s0 : s0; v1[e] = op == 2 ? v1[e] * s1 : s1; } }
                        u32x4 w; w.x = cvt_pk_bf16(v0[0], v0[1]); w.y = cvt_pk_bf16(v0[2], v0[3]); w.z = cvt_pk_bf16(v1[0], v1[1]); w.w = cvt_pk_bf16(v1[2], v1[3]);
                        *(u32x4*)(O + (size_t)row * PJW + col0) = w;
                        if (nrm) { float q = bf_lo(w.x) * bf_lo(w.x) + bf_hi(w.x) * bf_hi(w.x) + bf_lo(w.y) * bf_lo(w.y) + bf_hi(w.y) * bf_hi(w.y) + bf_lo(w.z) * bf_lo(w.z) + bf_hi(w.z) * bf_hi(w.z) + bf_lo(w.w) * bf_lo(w.w) + bf_hi(w.w) * bf_hi(w.w);
                            q += __shfl_xor(q, 16); q += __shfl_xor(q, 32); nmx = fmaxf(nmx, q); } }
                if (nrm) { nmx = fmaxf(nmx, __shfl_xor(nmx, 1)); nmx = fmaxf(nmx, __shfl_xor(nmx, 2)); nmx = fmaxf(nmx, __shfl_xor(nmx, 4)); nmx = fmaxf(nmx, __shfl_xor(nmx, 8));
                    if (fr == 0 && fq == 0) { const int bb = u.pm >> 5, qt = u.pm & 31, hd = ((hx - 10) & 3) * 2 + (wc >> 1), hf = wc & 1;
                        if (hx < 14) atomicMax(qmax2 + ((bb * 8 + hd) * 32 + qt) * 2 + hf, __float_as_uint(nmx)); else atomicMax(kmax2 + (bb * 8 + hd) * 2 + hf, __float_as_uint(nmx)); } }
            }
        }
    }
};
struct EpiMerge {
    static constexpr bool PERM = true, AFTER_DRAIN = false;
    const bf16_t* PJ; bf16_t* MG;
    __device__ __forceinline__ void operator()(const f32x4 (&acc)[2][2][4][2], const Unit& u, int wr, int wc, int fr, int fq) const {
        const int row0 = u.pm * BM + wr * 64 + fr, col0 = u.pn * BM + wc * 32 + 8 * fq, gc0 = 3328 + u.z * 1024 + col0;
#pragma unroll
        for (int ai = 0; ai < 2; ++ai)
#pragma unroll
            for (int m = 0; m < 4; ++m) { const int row = row0 + ai * HALF + m * 16;
#pragma unroll
                for (int bj = 0; bj < 2; ++bj) { const u32x4 g = *(const u32x4*)(PJ + (size_t)row * PJW + gc0 + bj * HALF); bf16_t* dst = MG + (size_t)row * 1024 + col0 + bj * HALF;
                    f32x4 v0 = acc[ai][bj][m][0], v1 = acc[ai][bj][m][1];
                    v0[0] *= bf_lo(g.x); v0[1] *= bf_hi(g.x); v0[2] *= bf_lo(g.y); v0[3] *= bf_hi(g.y); v1[0] *= bf_lo(g.z); v1[1] *= bf_hi(g.z); v1[2] *= bf_lo(g.w); v1[3] *= bf_hi(g.w);
                    if (u.z) { const u32x4 p = *(const u32x4*)dst; v0[0] += bf_lo(p.x); v0[1] += bf_hi(p.x); v0[2] += bf_lo(p.y); v0[3] += bf_hi(p.y); v1[0] += bf_lo(p.z); v1[1] += bf_hi(p.z); v1[2] += bf_lo(p.w); v1[3] += bf_hi(p.w); }
                    u32x4 w; w.x = cvt_pk_bf16(v0[0], v0[1]); w.y = cvt_pk_bf16(v0[2], v0[3]); w.z = cvt_pk_bf16(v1[0], v1[1]); w.w = cvt_pk_bf16(v1[2], v1[3]);
                    *(u32x4*)dst = w; } }
    }
};
struct EpiOut {
    static constexpr bool PERM = true, AFTER_DRAIN = false;
    const float* x; const float* gate; float* out; float* rss;
    __device__ __forceinline__ void operator()(const f32x4 (&acc)[2][2][4][2], const Unit& u, int wr, int wc, int fr, int fq) const {
        const int row0 = u.pm * BM + wr * 64 + fr, col0 = u.pn * BM + wc * 32 + 8 * fq; const float* gp = gate + (u.pm >> 5) * 1024 + col0;
        f32x4 gv[2][2];
#pragma unroll
        for (int bj = 0; bj < 2; ++bj)
#pragma unroll
            for (int n = 0; n < 2; ++n) gv[bj][n] = *(const f32x4*)(gp + bj * HALF + 4 * n);
#pragma unroll
        for (int ai = 0; ai < 2; ++ai)
#pragma unroll
            for (int m = 0; m < 4; ++m) { const int row = row0 + ai * HALF + m * 16; const size_t off = (size_t)row * 1024 + col0; float ss = 0.f;
#pragma unroll
                for (int bj = 0; bj < 2; ++bj)
#pragma unroll
                    for (int n = 0; n < 2; ++n) { const f32x4 xv = *(const f32x4*)(x + off + bj * HALF + 4 * n); const f32x4 o = xv + gv[bj][n] * acc[ai][bj][m][n];
                        *(f32x4*)(out + off + bj * HALF + 4 * n) = o; ss += (o[0] * o[0] + o[1] * o[1]) + (o[2] * o[2] + o[3] * o[3]); }
                ss += __shfl_xor(ss, 16); ss += __shfl_xor(ss, 32);
                if (fq == 0) rss[(size_t)row * 16 + u.pn * 4 + wc] = ss; }
    }
};

template <class Epi, class Sched, bool ALIGN_EPI = false, bool SP2 = false>
__device__ __forceinline__ void gemm_phase(PG8_LAS unsigned char* lds, const Gemm g, const Sched& S, const Epi& E) {
    int tid_ = threadIdx.x; asm volatile("" : "+v"(tid_));
    const int tid = tid_, wid = __builtin_amdgcn_readfirstlane(tid >> 6), lane = tid & 63, wr = wid >> 2, wc = wid & 3, fr = lane & 15, fq = lane >> 4;
    const int K = g.K, nt = K / BK;
    unsigned voffA[2], voffB[2];
#pragma unroll
    for (int i = 0; i < 2; ++i) { int R, C; stage_rc(tid * 16 + i * 8192, R, C); const int Rb = Epi::PERM ? ((R & ~31) + perm32(R & 31)) : R;
        voffA[i] = (unsigned)(R * g.lda + C) * 2u; voffB[i] = (unsigned)(Rb * K + C) * 2u; }
    const size_t kstep = (size_t)(BK * 2);
    const size_t hstepA = (size_t)HALF * g.lda * 2, hstepB = (size_t)HALF * K * 2;
    const size_t tstepA = 2 * hstepA, tstepB = 2 * hstepB;
    const unsigned ldsw = (unsigned)wid * 1024u;
    const int aoff = lds_byte(wr * 64 + fr, fq * 8), boff = lds_byte(wc * 32 + fr, fq * 8);
#define PG8_SA(b, h) (((b) * 2 + (h)) * HTB)
#define PG8_SB(b, h) ((4 + (b) * 2 + (h)) * HTB)
#define PG8_STAGE(bufoff, gbase, voff) do { _Pragma("unroll") for (int _i = 0; _i < 2; ++_i) \
        __builtin_amdgcn_global_load_lds((const unsigned*)((const char*)(gbase) + (voff)[_i]), (PG8_LAS unsigned*)(lds + (bufoff) + ldsw + _i * 8192), 16, 0, 0); } while (0)
#define PG8_LDA(dst, b, h) do { _Pragma("unroll") for (int m = 0; m < 4; ++m) _Pragma("unroll") for (int k = 0; k < 2; ++k) dst[m][k] = *(const PG8_LAS bf16x8*)(lds + PG8_SA(b, h) + aoff + m * 2048 + k * 1024); } while (0)
#define PG8_LDB(dst, b, h) do { _Pragma("unroll") for (int n = 0; n < 2; ++n) _Pragma("unroll") for (int k = 0; k < 2; ++k) dst[n][k] = *(const PG8_LAS bf16x8*)(lds + PG8_SB(b, h) + boff + n * 2048 + k * 1024); } while (0)
#define PG8_MMA(ai, bj, At, Bt) do { __builtin_amdgcn_s_setprio(1); _Pragma("unroll") for (int m = 0; m < 4; ++m) _Pragma("unroll") for (int n = 0; n < 2; ++n) _Pragma("unroll") for (int k = 0; k < 2; ++k) \
        acc[ai][bj][m][n] = __builtin_amdgcn_mfma_f32_16x16x32_bf16(Bt[n][k], At[m][k], acc[ai][bj][m][n], 0, 0, 0); __builtin_amdgcn_s_setprio(0); } while (0)
#define PG8_WAIT_V(n) asm volatile("s_waitcnt vmcnt(" #n ")" ::: "memory")
#define PG8_WAIT_L(n) asm volatile("s_waitcnt lgkmcnt(" #n ")" ::: "memory")
#define PG8_BAR __builtin_amdgcn_s_barrier()
#define PG8_SCHED __builtin_amdgcn_sched_barrier(0)
    Unit cur, nxt; int ui = 0;
    if (!S.next(0, cur)) return;
    f32x4 acc[2][2][4][2];
#pragma unroll
    for (int a = 0; a < 2; ++a)
#pragma unroll
        for (int b = 0; b < 2; ++b)
#pragma unroll
            for (int m = 0; m < 4; ++m)
#pragma unroll
                for (int n = 0; n < 2; ++n) acc[a][b][m][n] = (f32x4){0.f, 0.f, 0.f, 0.f};
    bf16x8 At[4][2], B0[2][2], B1[2][2];
    const char* cA = (const char*)(cur.z ? g.A2 : g.A) + (size_t)cur.pm * tstepA; const char* cB = (const char*)(cur.z ? g.Bt2 : g.Bt) + (size_t)cur.pn * tstepB;
    S.a_ready(cur);
    if constexpr (SP2) {
        PG8_STAGE(PG8_SB(0, 0), cB, voffB); PG8_STAGE(PG8_SB(0, 1), cB + hstepB, voffB); PG8_STAGE(PG8_SA(0, 0), cA, voffA); PG8_STAGE(PG8_SA(0, 1), cA + hstepA, voffA);
        if (wr == 1) PG8_BAR;
        PG8_WAIT_V(2); PG8_BAR;
        PG8_STAGE(PG8_SB(1, 0), cB + kstep, voffB); PG8_STAGE(PG8_SA(1, 0), cA + kstep, voffA); PG8_STAGE(PG8_SB(1, 1), cB + hstepB + kstep, voffB);
        PG8_WAIT_V(6); PG8_BAR;
    } else {
        PG8_STAGE(PG8_SB(0, 0), cB, voffB); PG8_STAGE(PG8_SA(0, 0), cA, voffA); PG8_STAGE(PG8_SB(0, 1), cB + hstepB, voffB); PG8_STAGE(PG8_SA(0, 1), cA + hstepA, voffA);
        if (wr == 1) PG8_BAR;
        PG8_WAIT_V(4); PG8_BAR;
        PG8_STAGE(PG8_SB(1, 0), cB + kstep, voffB); PG8_STAGE(PG8_SA(1, 0), cA + kstep, voffA); PG8_STAGE(PG8_SB(1, 1), cB + hstepB + kstep, voffB);
        PG8_WAIT_V(6); PG8_BAR;
    }
    for (;;) {
        const bool has_next = S.next(ui + 1, nxt);
        const char* nA = has_next ? (const char*)(nxt.z ? g.A2 : g.A) + (size_t)nxt.pm * tstepA : cA; const char* nB = has_next ? (const char*)(nxt.z ? g.Bt2 : g.Bt) + (size_t)nxt.pn * tstepB : cB;
        for (int t = 0; t < nt; t += 2) {
            const bool last = (t == nt - 2);
            const char* a1 = cA + (size_t)(t + 1) * kstep;
            const char* a2 = last ? nA : cA + (size_t)(t + 2) * kstep; const char* b2 = last ? nB : cB + (size_t)(t + 2) * kstep;
            const char* a3 = a2 + kstep; const char* b3 = b2 + kstep;
            if (last && has_next) S.a_ready(nxt);
            if constexpr (SP2) {
            PG8_LDB(B0, 0, 0); PG8_LDB(B1, 0, 1); PG8_SCHED; PG8_LDA(At, 0, 0); PG8_STAGE(PG8_SA(1, 1), a1 + hstepA, voffA);
            PG8_WAIT_V(8); PG8_WAIT_L(0); PG8_BAR; PG8_MMA(0, 0, At, B0); PG8_MMA(0, 1, At, B1); PG8_BAR; PG8_SCHED;
            PG8_LDA(At, 0, 1); PG8_STAGE(PG8_SB(0, 0), b2, voffB); PG8_STAGE(PG8_SB(0, 1), b2 + hstepB, voffB); PG8_STAGE(PG8_SA(0, 0), a2, voffA);
            PG8_WAIT_V(8); PG8_WAIT_L(0); PG8_BAR; PG8_MMA(1, 0, At, B0); PG8_MMA(1, 1, At, B1); PG8_BAR; PG8_SCHED;
            PG8_LDB(B0, 1, 0); PG8_LDB(B1, 1, 1); PG8_SCHED; PG8_LDA(At, 1, 0); PG8_STAGE(PG8_SA(0, 1), a2 + hstepA, voffA);
            PG8_WAIT_V(8); PG8_WAIT_L(0); PG8_BAR; PG8_MMA(0, 0, At, B0); PG8_MMA(0, 1, At, B1); PG8_BAR; PG8_SCHED;
            PG8_LDA(At, 1, 1); PG8_STAGE(PG8_SB(1, 0), b3, voffB); PG8_STAGE(PG8_SB(1, 1), b3 + hstepB, voffB); PG8_STAGE(PG8_SA(1, 0), a3, voffA);
            PG8_WAIT_V(8); PG8_WAIT_L(0); PG8_BAR; PG8_MMA(1, 0, At, B0); PG8_MMA(1, 1, At, B1); PG8_BAR; PG8_SCHED;
            } else {
            PG8_LDB(B0, 0, 0); PG8_SCHED; PG8_LDA(At, 0, 0); PG8_STAGE(PG8_SA(1, 1), a1 + hstepA, voffA);
            PG8_WAIT_L(8); PG8_BAR; PG8_WAIT_L(0); PG8_MMA(0, 0, At, B0); PG8_BAR; PG8_SCHED;
            PG8_LDB(B1, 0, 1); PG8_STAGE(PG8_SB(0, 0), b2, voffB);
            PG8_BAR; PG8_WAIT_L(0); PG8_MMA(0, 1, At, B1); PG8_BAR;
            PG8_LDA(At, 0, 1); PG8_STAGE(PG8_SA(0, 0), a2, voffA);
            PG8_BAR; PG8_WAIT_L(0); PG8_MMA(1, 0, At, B0); PG8_BAR; PG8_SCHED;
            PG8_STAGE(PG8_SB(0, 1), b2 + hstepB, voffB);
            PG8_WAIT_V(6); PG8_BAR; PG8_MMA(1, 1, At, B1); PG8_BAR;
            PG8_LDB(B0, 1, 0); PG8_SCHED; PG8_LDA(At, 1, 0); PG8_STAGE(PG8_SA(0, 1), a2 + hstepA, voffA);
            PG8_WAIT_L(8); PG8_BAR; PG8_WAIT_L(0); PG8_MMA(0, 0, At, B0); PG8_BAR; PG8_SCHED;
            PG8_LDB(B1, 1, 1); PG8_STAGE(PG8_SB(1, 0), b3, voffB);
            PG8_BAR; PG8_WAIT_L(0); PG8_MMA(0, 1, At, B1); PG8_BAR;
            PG8_LDA(At, 1, 1); PG8_STAGE(PG8_SA(1, 0), a3, voffA);
            PG8_BAR; PG8_WAIT_L(0); PG8_MMA(1, 0, At, B0); PG8_BAR; PG8_SCHED;
            PG8_STAGE(PG8_SB(1, 1), b3 + hstepB, voffB);
            PG8_WAIT_V(6); PG8_BAR; PG8_MMA(1, 1, At, B1); PG8_BAR;
            }
        }
        if constexpr (ALIGN_EPI) { if (wr == 0) PG8_BAR; }
        if constexpr (!Epi::AFTER_DRAIN) { E(acc, cur, wr, wc, fr, fq); S.done(cur); }
        if (!has_next) break;
#pragma unroll
        for (int a = 0; a < 2; ++a)
#pragma unroll
            for (int b = 0; b < 2; ++b)
#pragma unroll
                for (int m = 0; m < 4; ++m)
#pragma unroll
                    for (int n = 0; n < 2; ++n) acc[a][b][m][n] = (f32x4){0.f, 0.f, 0.f, 0.f};
        cur = nxt; cA = nA; cB = nB; ++ui;
        if constexpr (ALIGN_EPI) { if (wr == 1) PG8_BAR; }
    }
    PG8_WAIT_V(0);
    if constexpr (!ALIGN_EPI) { if (wr == 0) PG8_BAR; }
    PG8_BAR;
    if constexpr (Epi::AFTER_DRAIN) { E.fused(acc, cur, wr, wc, fr, fq, lds, wid, lane); S.done(cur); }
#undef PG8_SA
#undef PG8_SB
#undef PG8_STAGE
#undef PG8_LDA
#undef PG8_LDB
#undef PG8_MMA
#undef PG8_WAIT_V
#undef PG8_WAIT_L
#undef PG8_BAR
#undef PG8_SCHED
}
}

#include <hip/hip_bf16.h>
#include <cmath>
namespace attn_body {
using bf16=__hip_bfloat16;
using bf16x8=__attribute__((ext_vector_type(8)))short;
using s16x4=__attribute__((ext_vector_type(4)))short;
using f32x16=__attribute__((ext_vector_type(16)))float;
using u32x4=__attribute__((ext_vector_type(4)))unsigned;
constexpr int BATCH=4,NHEAD=8,SEQ=8192,D=64,DM=5376,ODM=1024;
constexpr int NW=8,QBLK=32,QB=QBLK*NW,KVBLK=64,NQB=SEQ/QB;
constexpr int ATTN_PITCH=DM, ATTN_UNIT_ROWS=QB;
__device__ __forceinline__ int crow(int r,int hi){return (r&3)+8*(r>>2)+4*hi;}
#define SBAR() __builtin_amdgcn_sched_barrier(0)
__device__ __forceinline__ void cmask(f32x16&p0,f32x16&p1,int jb,int qrel,int hi){
  const float NEG=-INFINITY; int kb=64*jb+4*hi;
  #pragma unroll
  for(int r=0;r<16;++r){int kv=kb+(r&3)+8*(r>>2); if(kv>qrel)p0[r]=NEG; if(kv+32>qrel)p1[r]=NEG;}
}

constexpr int NSLOT=3, SLOTB=8192;
constexpr int LDS_K=0, LDS_V=NSLOT*SLOTB, LDS_WS=2*NSLOT*SLOTB, LDS_OST=LDS_WS+NW*64*4, LDS_CB=LDS_OST+NW*4096, LDS_BYTES=LDS_CB+SEQ*4;
constexpr float C2=0.125f*1.4426950408889634f;
__device__ __forceinline__ void glds16(const void*gsrc,unsigned lds_dst){unsigned keep;
  asm volatile("s_mov_b32 %0, m0\n\ts_mov_b32 m0, %2\n\ts_nop 0\n\tglobal_load_lds_dwordx4 %1, off\n\ts_mov_b32 m0, %0":"=&s"(keep):"v"(gsrc),"s"(lds_dst):"memory");}
__device__ __forceinline__ float max3f(float a,float b,float c){float r;asm("v_max3_f32 %0, %1, %2, %3":"=v"(r):"v"(a),"v"(b),"v"(c));return r;}
__device__ __forceinline__ float max2f(float a,float b){float r;asm("v_max_f32_e32 %0, %1, %2":"=v"(r):"v"(a),"v"(b));return r;}
__device__ __forceinline__ float fadd_s(float a,float b){float r;asm("v_add_f32_e32 %0, %1, %2":"=v"(r):"v"(a),"v"(b));return r;}
__device__ __forceinline__ float fsub_s(float a,float b){float r;asm("v_sub_f32_e32 %0, %1, %2":"=v"(r):"v"(a),"v"(b));return r;}
typedef float f32x2_t __attribute__((ext_vector_type(2))); typedef __bf16 bf16x2_t __attribute__((ext_vector_type(2)));
__device__ __forceinline__ unsigned cvtpk_s(float lo,float hi){f32x2_t v={lo,hi};bf16x2_t b=__builtin_convertvector(v,bf16x2_t);return __builtin_bit_cast(unsigned,b);}
#define WAIT_BAR(N) asm volatile("s_waitcnt vmcnt(" #N ") lgkmcnt(0)\n\ts_barrier":::"memory")

__device__ __forceinline__ void qkt(f32x16&p0,f32x16&p1,const char*Kslot,const bf16x8*qr,int r32,int hi){
  const char*kb=Kslot+hi*1024+r32*16;
  #pragma unroll
  for(int d0=0;d0<4;++d0){
    const bf16x8 b0=*reinterpret_cast<const bf16x8*>(kb+d0*2048);
    const bf16x8 b1=*reinterpret_cast<const bf16x8*>(kb+d0*2048+512);
    p0=__builtin_amdgcn_mfma_f32_32x32x16_bf16(b0,qr[d0],p0,0,0,0);p1=__builtin_amdgcn_mfma_f32_32x32x16_bf16(b1,qr[d0],p1,0,0,0);}
}
typedef __attribute__((address_space(3))) const char* lds_cptr;
typedef short v4i16_t __attribute__((ext_vector_type(4)));
__device__ __forceinline__ void kload8(bf16x8*kf,lds_cptr kp){
  kf[0]=*(const __attribute__((address_space(3))) bf16x8*)(kp);      kf[1]=*(const __attribute__((address_space(3))) bf16x8*)(kp+512);
  kf[2]=*(const __attribute__((address_space(3))) bf16x8*)(kp+2048); kf[3]=*(const __attribute__((address_space(3))) bf16x8*)(kp+2560);
  kf[4]=*(const __attribute__((address_space(3))) bf16x8*)(kp+4096); kf[5]=*(const __attribute__((address_space(3))) bf16x8*)(kp+4608);
  kf[6]=*(const __attribute__((address_space(3))) bf16x8*)(kp+6144); kf[7]=*(const __attribute__((address_space(3))) bf16x8*)(kp+6656);
}
__device__ __forceinline__ void kload2(bf16x8*kf,lds_cptr kp,int j){ kf[2*j]=*(const __attribute__((address_space(3))) bf16x8*)(kp+j*2048); kf[2*j+1]=*(const __attribute__((address_space(3))) bf16x8*)(kp+j*2048+512); }
__device__ __forceinline__ s16x4 vtr(lds_cptr p){ return __builtin_bit_cast(s16x4,__builtin_amdgcn_ds_read_tr16_b64_v4i16((__attribute__((address_space(3))) v4i16_t*)p)); }
__device__ __forceinline__ float rowmax(const f32x16&p0,const f32x16&p1){
  float a=max3f(p0[0],p0[1],p1[0]),b=max3f(p0[2],p0[3],p1[1]);a=max3f(a,p1[2],p1[3]);
  #pragma unroll
  for(int r=4;r<16;r+=4){a=max3f(a,p0[r],p0[r+1]);b=max3f(b,p0[r+2],p0[r+3]);a=max3f(a,p1[r],p1[r+1]);b=max3f(b,p1[r+2],p1[r+3]);}
  const float m=max2f(a,b);
  auto rr=__builtin_amdgcn_permlane32_swap(__float_as_uint(m),__float_as_uint(m),false,false);
  return max2f(__uint_as_float(rr[0]),__uint_as_float(rr[1]));
}
__device__ __forceinline__ void pv(f32x16*o,int vb,bf16x8 pa0,bf16x8 pa1,bf16x8 pa2,bf16x8 pa3){
  #pragma unroll
  for(int d0=0;d0<2;++d0){s16x4 lo[4],hi[4];
    #pragma unroll
    for(int ks=0;ks<4;++ks){
      asm volatile("ds_read_b64_tr_b16 %0,%1 offset:%c2":"=&v"(lo[ks]):"v"(vb),"i"(d0*4096+ks*1024):"memory");
      asm volatile("ds_read_b64_tr_b16 %0,%1 offset:%c2":"=&v"(hi[ks]):"v"(vb),"i"(d0*4096+ks*1024+512):"memory");}
    asm volatile("s_waitcnt lgkmcnt(0)":::"memory");SBAR();
    #define PK(k) (bf16x8){lo[k][0],lo[k][1],lo[k][2],lo[k][3],hi[k][0],hi[k][1],hi[k][2],hi[k][3]}
    o[d0]=__builtin_amdgcn_mfma_f32_32x32x16_bf16(pa0,PK(0),o[d0],0,0,0);
    o[d0]=__builtin_amdgcn_mfma_f32_32x32x16_bf16(pa1,PK(1),o[d0],0,0,0);
    o[d0]=__builtin_amdgcn_mfma_f32_32x32x16_bf16(pa2,PK(2),o[d0],0,0,0);
    o[d0]=__builtin_amdgcn_mfma_f32_32x32x16_bf16(pa3,PK(3),o[d0],0,0,0);
    #undef PK
  }
}

typedef float f32x4v __attribute__((ext_vector_type(4)));
__device__ __forceinline__ u32x4 mul_bf16x8(u32x4 a,u32x4 z){u32x4 r;
  #pragma unroll
  for(int i=0;i<4;++i){const float al=__uint_as_float(a[i]<<16),ah=__uint_as_float(a[i]&0xffff0000u),zl=__uint_as_float(z[i]<<16),zh=__uint_as_float(z[i]&0xffff0000u);r[i]=cvtpk_s(al*zl,ah*zh);}
  return r;}
#ifndef ATTN_STORE16
#define ATTN_STORE16(p,v) (*(u32x4*)(p)=(v))
#endif
template<int THRL> __device__ __forceinline__ void attn_unit(int b,int h,int qb,const bf16*Q,const bf16*__restrict__ K,const bf16*__restrict__ V,bf16*O,const bf16*__restrict__ Z,const float*__restrict__ cumh,int t0,char*shm){
  int tid_=threadIdx.x; asm volatile("":"+v"(tid_)); const int tid=tid_,lane=tid&63,r32=lane&31,hi=lane>>5; const int wid=__builtin_amdgcn_readfirstlane(tid>>6);
  const long rowbase=(long)b*SEQ; const int q0=qb*QB;
  const bf16*Qw=Q+(rowbase+q0+wid*QBLK)*DM+h*D;
  const bf16*Kh=K+(rowbase+(long)t0*KVBLK)*DM+h*D,*Vh=V+(rowbase+(long)t0*KVBLK)*DM+h*D;
  const unsigned lds0=(unsigned)(uintptr_t)shm;
  float*wsf=(float*)(shm+LDS_WS)+wid*64;
  const bf16*ksrc=Kh+(long)lane*DM+wid*8;
  const bf16*vsrc=Vh+(long)(16*(wid&3)+(lane>>2))*DM+(wid>>2)*32+(lane&3)*8;
  const unsigned kdst=lds0+LDS_K+wid*1024, vdst=lds0+LDS_V+wid*1024;
  #define DMA_K(t,slot) glds16(ksrc+(long)(t)*KVBLK*DM,(unsigned)__builtin_amdgcn_readfirstlane(kdst+(slot)))
  #define DMA_V(t,slot) glds16(vsrc+(long)(t)*KVBLK*DM,(unsigned)__builtin_amdgcn_readfirstlane(vdst+(slot)))
  const int vb0=(int)(lds0+LDS_V)+((lane>>4)&1)*32+(lane&3)*8+(4*hi+((lane&15)>>2))*64;
  const char*Kbase=shm+LDS_K; bf16x8 kf[8];
  const lds_cptr shm3=(lds_cptr)shm; const lds_cptr kp0=shm3+LDS_K+hi*1024+r32*16; const lds_cptr vp0=shm3+LDS_V+((lane>>4)&1)*32+(lane&3)*8+(4*hi+((lane&15)>>2))*64;
  const int NT=(q0+QB)/KVBLK-t0;
  DMA_K(0,0);DMA_V(0,0);DMA_K(1,SLOTB);
  bf16x8 qr[4];
  #pragma unroll
  for(int d0=0;d0<4;++d0)qr[d0]=*reinterpret_cast<const bf16x8*>(&Qw[(long)r32*DM+d0*16+hi*8]);
  float mhat=0.f,l_reg=0.f;f32x16 o[2];o[0]=f32x16{};o[1]=f32x16{};
  const int qrel=wid*QBLK+r32;
  #define CMASK(P0,P1,t) do{int jb_=(t)-(NT-4); if(jb_>=0)cmask(P0,P1,jb_,qrel,hi);}while(0)
  bool resc=false;
  #define START(P0,P1) do{ const float rm=rowmax(P0,P1); resc=false; \
    { const float dl=rm; mhat=fadd_s(mhat,dl); \
      _Pragma("unroll") for(int r=0;r<16;++r){P0[r]=fsub_s(P0[r],dl);P1[r]=fsub_s(P1[r],dl);} \
      } \
    _Pragma("unroll") for(int r=0;r<16;++r)P0[r]=__builtin_amdgcn_exp2f(P0[r]); }while(0)
  #define RESC() do{ if(resc){ asm volatile("s_waitcnt lgkmcnt(0)":::"memory"); \
      _Pragma("unroll") for(int d_=0;d_<2;++d_) _Pragma("unroll") for(int r=0;r<16;++r)o[d_][r]*=wsf[crow(r,hi)]; } }while(0)
  f32x16 pA0,pA1,pB0,pB1;
  int sl_prev=0,sl_cur=0,sl_next=SLOTB;
  #define ROT() do{sl_prev=sl_cur;sl_cur=sl_next;sl_next=(sl_next==(NSLOT-1)*SLOTB)?0:sl_next+SLOTB;}while(0)
  DMA_K(2,2*SLOTB);
  typedef __attribute__((address_space(3))) float lds_f32; typedef __attribute__((address_space(3))) f32x4v lds_f32x4;
  lds_f32* const cb3=(lds_f32*)((__attribute__((address_space(3))) char*)shm+LDS_CB);
  { const float cref=cumh[q0]; const float*cs=cumh+t0*KVBLK; for(int i=tid;i<NT*KVBLK;i+=NW*64) cb3[i]=(cref-cs[i])*1.4426950408889634f; }
  #define CBLD(P0,P1,t) do{ const lds_f32x4* cp_=(const lds_f32x4*)(cb3+(t)*KVBLK+4*hi); \
    _Pragma("unroll") for(int g_=0;g_<4;++g_){ const f32x4v a_=cp_[2*g_], b_=cp_[8+2*g_]; \
      P0[4*g_]=a_[0]-mhat; P0[4*g_+1]=a_[1]-mhat; P0[4*g_+2]=a_[2]-mhat; P0[4*g_+3]=a_[3]-mhat; \
      P1[4*g_]=b_[0]-mhat; P1[4*g_+1]=b_[1]-mhat; P1[4*g_+2]=b_[2]-mhat; P1[4*g_+3]=b_[3]-mhat; } }while(0)
  WAIT_BAR(3);
  CBLD(pA0,pA1,0); qkt(pA0,pA1,Kbase,qr,r32,hi);asm volatile("s_nop 15\n\ts_nop 7":"+v"(pA0),"+v"(pA1));CMASK(pA0,pA1,0);
  START(pA0,pA1);
  _Pragma("unroll") for(int r=0;r<16;++r)pA1[r]=__builtin_amdgcn_exp2f(pA1[r]);
  WAIT_BAR(0);
  DMA_K(3,0);DMA_V(1,SLOTB);
  ROT();
  kload8(kf,kp0+sl_cur);
  WAIT_BAR(2);
  s16x4 vlo[8],vhi[8]; u32x4 pw0,pw1,pw2,pw3;
  #define PKW(P,B) cvtpk_s(P[B],P[B+1])
  #define PAF(k) __builtin_bit_cast(bf16x8,pw##k)
  #define VFR(i) (bf16x8){vlo[i][0],vlo[i][1],vlo[i][2],vlo[i][3],vhi[i][0],vhi[i][1],vhi[i][2],vhi[i][3]}
  #define PIN(x) asm volatile("":"+v"(x))
  #define MX3(a,b,c) __builtin_fmaxf(__builtin_fmaxf((a),(b)),(c))
  #define GAPA(MF,A0,A1,A2,A3,W0,W1,PW) do{ MF; sacc+=A0; sacc+=A1; sacc+=A2; sacc+=A3; PIN(sacc); W0; W1; PIN(PW); SBAR(); }while(0)
  #define EX(v) __builtin_amdgcn_exp2f(v)
  #define GAPB(MF,X,B) do{ MF; X[B]=EX(X[B]); X[B+1]=EX(X[B+1]); X[B+2]=EX(X[B+2]); X[B+3]=EX(X[B+3]); PIN(X); SBAR(); }while(0)
  #define VRD(i) do{ vlo[i]=vtr(vp_+(((i)>>2)*4096+((i)&3)*1024)); vhi[i]=vtr(vp_+(((i)>>2)*4096+((i)&3)*1024+512)); }while(0)
  #define KRD(G,j) do{ if(G){ kload2(kf,kp0+sl_next,j); SBAR(); } }while(0)
  #define STEP(C0,C1,P0,P1,t,GK,GV,GL) do{ SBAR(); \
    const lds_cptr vp_=vp0+sl_prev; \
    VRD(0); SBAR(); float sacc=(P0[0]+P0[1]); \
    GAPA(C0=__builtin_amdgcn_mfma_f32_32x32x16_bf16(kf[0],qr[0],C0,0,0,0), P0[2],P0[3],P0[4],P0[5],     pw0[0]=PKW(P0,0), pw0[1]=PKW(P0,2), pw0); \
    VRD(4); SBAR(); GAPA(C1=__builtin_amdgcn_mfma_f32_32x32x16_bf16(kf[1],qr[0],C1,0,0,0), P0[6],P0[7],P0[8],P0[9],     pw0[2]=PKW(P0,4), pw0[3]=PKW(P0,6), pw0); \
    VRD(1); SBAR(); GAPA(C0=__builtin_amdgcn_mfma_f32_32x32x16_bf16(kf[2],qr[1],C0,0,0,0),   P0[10],P0[11],P0[12],P0[13], pw1[0]=PKW(P0,8), pw1[1]=PKW(P0,10), pw1); \
    VRD(5); SBAR(); GAPA(C1=__builtin_amdgcn_mfma_f32_32x32x16_bf16(kf[3],qr[1],C1,0,0,0),   P0[14],P0[15],P1[0],P1[1],   pw1[2]=PKW(P0,12),pw1[3]=PKW(P0,14), pw1); \
    VRD(2); SBAR(); GAPA(C0=__builtin_amdgcn_mfma_f32_32x32x16_bf16(kf[4],qr[2],C0,0,0,0),   P1[2],P1[3],P1[4],P1[5],     pw2[0]=PKW(P1,0), pw2[1]=PKW(P1,2), pw2); \
    VRD(6); SBAR(); GAPA(C1=__builtin_amdgcn_mfma_f32_32x32x16_bf16(kf[5],qr[2],C1,0,0,0),   P1[6],P1[7],P1[8],P1[9],     pw2[2]=PKW(P1,4), pw2[3]=PKW(P1,6), pw2); \
    VRD(3); SBAR(); GAPA(C0=__builtin_amdgcn_mfma_f32_32x32x16_bf16(kf[6],qr[3],C0,0,0,0),   P1[10],P1[11],P1[12],P1[13], pw3[0]=PKW(P1,8), pw3[1]=PKW(P1,10), pw3); \
    VRD(7); SBAR(); GAPA(C1=__builtin_amdgcn_mfma_f32_32x32x16_bf16(kf[7],qr[3],C1,0,0,0),   P1[14],P1[15],0.f,0.f,       pw3[2]=PKW(P1,12),pw3[3]=PKW(P1,14), pw3); \
    l_reg+=sacc; \
    if(GK){DMA_K((t)+3,sl_cur);} if(GV){DMA_V((t)+1,sl_next);} \
    CMASK(C0,C1,t); \
    { float a=MX3(C0[0],C0[1],C1[0]),b=MX3(C0[2],C0[3],C1[1]); a=MX3(a,C1[2],C1[3]); \
      _Pragma("unroll") for(int r=4;r<16;r+=4){a=MX3(a,C0[r],C0[r+1]);b=MX3(b,C0[r+2],C0[r+3]);a=MX3(a,C1[r],C1[r+1]);b=MX3(b,C1[r+2],C1[r+3]);} \
      float rm=__builtin_fmaxf(a,b); { auto rr=__builtin_amdgcn_permlane32_swap(__float_as_uint(rm),__float_as_uint(rm),false,false); rm=__builtin_fmaxf(__uint_as_float(rr[0]),__uint_as_float(rr[1])); } \
      resc=false; \
      if(__builtin_expect(__any(rm>(float)THRL),0)){ const float dl=__builtin_fmaxf(rm,0.f); mhat+=dl; \
        _Pragma("unroll") for(int r=0;r<16;++r){C0[r]-=dl;C1[r]-=dl;} \
        const float f=__builtin_amdgcn_exp2f(-dl); l_reg*=f; if(hi==0)wsf[r32]=f; resc=true; } } \
    SBAR(); \
    GAPB(o[0]=__builtin_amdgcn_mfma_f32_32x32x16_bf16(PAF(0),VFR(0),o[0],0,0,0), C0,0); \
    GAPB(o[1]=__builtin_amdgcn_mfma_f32_32x32x16_bf16(PAF(0),VFR(4),o[1],0,0,0), C0,4); \
    KRD(GL,0); GAPB(o[0]=__builtin_amdgcn_mfma_f32_32x32x16_bf16(PAF(1),VFR(1),o[0],0,0,0), C0,8); \
    KRD(GL,1); GAPB(o[1]=__builtin_amdgcn_mfma_f32_32x32x16_bf16(PAF(1),VFR(5),o[1],0,0,0), C0,12); \
    KRD(GL,2); GAPB(o[0]=__builtin_amdgcn_mfma_f32_32x32x16_bf16(PAF(2),VFR(2),o[0],0,0,0), C1,0); \
    KRD(GL,3); GAPB(o[1]=__builtin_amdgcn_mfma_f32_32x32x16_bf16(PAF(2),VFR(6),o[1],0,0,0), C1,4); \
    GAPB(o[0]=__builtin_amdgcn_mfma_f32_32x32x16_bf16(PAF(3),VFR(3),o[0],0,0,0), C1,8); \
    GAPB(o[1]=__builtin_amdgcn_mfma_f32_32x32x16_bf16(PAF(3),VFR(7),o[1],0,0,0), C1,12); \
    if(GL){ CBLD(P0,P1,(t)+1); } \
    }while(0)
  CBLD(pB0,pB1,1);
  int t=1;
  #undef CMASK
  #define CMASK(P0,P1,t) do{}while(0)
  for(;t+5<NT;t+=2){
    STEP(pB0,pB1,pA0,pA1,t,true,true,true);     WAIT_BAR(2); RESC(); ROT();
    STEP(pA0,pA1,pB0,pB1,t+1,true,true,true);   WAIT_BAR(2); RESC(); ROT();
  }
  #undef CMASK
  #define CMASK(P0,P1,t) do{int jb_=(t)-(NT-4); if(jb_>=0)cmask(P0,P1,jb_,qrel,hi);}while(0)
  #define ENDW(tt) do{ if((tt)+3<NT){WAIT_BAR(2);} else if((tt)+2<NT){WAIT_BAR(1);} else {WAIT_BAR(0);} }while(0)
  for(;t+1<NT;t+=2){
    STEP(pB0,pB1,pA0,pA1,t,(t+3<NT),(t+1<NT),(t+1<NT));       ENDW(t);   RESC(); ROT();
    STEP(pA0,pA1,pB0,pB1,t+1,(t+4<NT),(t+2<NT),(t+2<NT));     ENDW(t+1); RESC(); ROT();
  }
  STEP(pB0,pB1,pA0,pA1,NT-1,false,false,false); RESC();
  { float sacc=pB0[0]+pB0[1]; _Pragma("unroll") for(int r=2;r<16;++r)sacc+=pB0[r]; _Pragma("unroll") for(int r=0;r<16;++r)sacc+=pB1[r]; l_reg+=sacc;
    pw0=(u32x4){PKW(pB0,0),PKW(pB0,2),PKW(pB0,4),PKW(pB0,6)};pw1=(u32x4){PKW(pB0,8),PKW(pB0,10),PKW(pB0,12),PKW(pB0,14)};pw2=(u32x4){PKW(pB1,0),PKW(pB1,2),PKW(pB1,4),PKW(pB1,6)};pw3=(u32x4){PKW(pB1,8),PKW(pB1,10),PKW(pB1,12),PKW(pB1,14)};
    SBAR(); pv(o,vb0+sl_cur,PAF(0),PAF(1),PAF(2),PAF(3)); }
  #undef PKW
  #undef PAF
  #undef VFR
  #undef PIN
  #undef MX3
  #undef GAPA
  #undef GAPB
  #undef EX
  #undef VRD
  #undef KRD
  #undef STEP
  #undef ENDW
  {auto rr=__builtin_amdgcn_permlane32_swap(__float_as_uint(l_reg),__float_as_uint(l_reg),false,false);l_reg=__uint_as_float(rr[0])+__uint_as_float(rr[1]);}
  if(hi==0)wsf[32+r32]=l_reg;asm volatile("s_waitcnt lgkmcnt(0)":::"memory");
  float rli[16];
  #pragma unroll
  for(int r=0;r<16;++r)rli[r]=__builtin_amdgcn_rcpf(wsf[32+crow(r,hi)]);
  bf16*Ow=O+(rowbase+q0+wid*QBLK)*ODM+h*D; const bf16*Zw=Z+(rowbase+q0+wid*QBLK)*DM+h*D;
  { bf16*stg=(bf16*)(shm+LDS_OST)+wid*2048;
    #pragma unroll
    for(int r=0;r<16;++r){const int orow=crow(r,hi);
      #pragma unroll
      for(int d0=0;d0<2;++d0)stg[orow*64+d0*32+r32]=__float2bfloat16(o[d0][r]*rli[r]);}
    asm volatile("s_waitcnt lgkmcnt(0)":::"memory");
    #pragma unroll
    for(int i=0;i<4;++i){const int row=i*8+(lane>>3),ch=lane&7; const u32x4 v=*(const u32x4*)(stg+row*64+ch*8); const u32x4 zz=*(const u32x4*)(Zw+(long)row*DM+ch*8); ATTN_STORE16(Ow+(long)row*ODM+ch*8,mul_bf16x8(v,zz));} }
  asm volatile("s_waitcnt lgkmcnt(0)\n\ts_barrier":::"memory");
  #undef CBLD
  #undef DMA_K
  #undef DMA_V
  #undef CMASK
  #undef START
  #undef RESC
  #undef ROT
}
constexpr int ATTN_LDS_BYTES=LDS_BYTES;
__device__ __forceinline__ void swa_unit(int b,int kvh,int blk,const bf16*__restrict__ PJ,bf16*__restrict__ OA,const float*__restrict__ sinks,char*shm){
  int tid_=threadIdx.x; asm volatile("":"+v"(tid_)); const int tid=tid_,lane=tid&63,r32=lane&31,hi=lane>>5; const int wid=__builtin_amdgcn_readfirstlane(tid>>6);
  const long rowbase=(long)b*SEQ; const int q0=blk*64,kb0=q0-128;
  const int hq=4*kvh+(wid>>1),r0=q0+32*(wid&1);
  const unsigned lds0=(unsigned)(uintptr_t)shm;
  float*wsf=(float*)(shm+LDS_WS)+wid*64;
  const bf16*Kh=PJ+rowbase*DM+512+kvh*D,*Vh=PJ+rowbase*DM+640+kvh*D;
  #pragma unroll
  for(int j=0;j<3;++j){
    int kr=kb0+64*j+lane; kr=kr<0?0:kr;
    glds16(Kh+(long)kr*DM+wid*8,(unsigned)__builtin_amdgcn_readfirstlane(lds0+LDS_K+j*SLOTB+wid*1024));
    int vr=kb0+64*j+16*(wid&3)+(lane>>2); vr=vr<0?0:vr;
    glds16(Vh+(long)vr*DM+(wid>>2)*32+(lane&3)*8,(unsigned)__builtin_amdgcn_readfirstlane(lds0+LDS_V+j*SLOTB+wid*1024));
  }
  const bf16*Qw=PJ+(rowbase+r0)*DM+hq*D;
  bf16x8 qr[4];
  #pragma unroll
  for(int d0=0;d0<4;++d0)qr[d0]=*reinterpret_cast<const bf16x8*>(&Qw[(long)r32*DM+d0*16+hi*8]);
  const float sk=sinks[hq]*1.4426950408889634f;
  WAIT_BAR(0);
  f32x16 p[3][2];
  #pragma unroll
  for(int j=0;j<3;++j){p[j][0]=f32x16{};p[j][1]=f32x16{};qkt(p[j][0],p[j][1],shm+LDS_K+j*SLOTB,qr,r32,hi);}
  const int q=r0+r32; float m=-INFINITY;
  #pragma unroll
  for(int j=0;j<3;++j)
    #pragma unroll
    for(int hf=0;hf<2;++hf)
      #pragma unroll
      for(int r=0;r<16;++r){const int kv=kb0+64*j+32*hf+crow(r,hi); const bool ok=(kv>=0)&&(kv<=q)&&(q-kv<128); const float v=ok?p[j][hf][r]:-INFINITY; p[j][hf][r]=v; m=__builtin_fmaxf(m,v);}
  {auto rr=__builtin_amdgcn_permlane32_swap(__float_as_uint(m),__float_as_uint(m),false,false); m=__builtin_fmaxf(__uint_as_float(rr[0]),__uint_as_float(rr[1]));}
  m=__builtin_fmaxf(m,sk);
  float l=0.f;
  #pragma unroll
  for(int j=0;j<3;++j)
    #pragma unroll
    for(int hf=0;hf<2;++hf)
      #pragma unroll
      for(int r=0;r<16;++r){const float e=__builtin_amdgcn_exp2f(p[j][hf][r]-m); p[j][hf][r]=e; l+=e;}
  {auto rr=__builtin_amdgcn_permlane32_swap(__float_as_uint(l),__float_as_uint(l),false,false); l=__uint_as_float(rr[0])+__uint_as_float(rr[1]);}
  l+=__builtin_amdgcn_exp2f(sk-m);
  f32x16 o[2]; o[0]=f32x16{}; o[1]=f32x16{};
  const int vb0=(int)(lds0+LDS_V)+((lane>>4)&1)*32+(lane&3)*8+(4*hi+((lane&15)>>2))*64;
  #pragma unroll
  for(int j=0;j<3;++j){
    #define PKW(P,B) cvtpk_s(P[B],P[B+1])
    const u32x4 pw0=(u32x4){PKW(p[j][0],0),PKW(p[j][0],2),PKW(p[j][0],4),PKW(p[j][0],6)},pw1=(u32x4){PKW(p[j][0],8),PKW(p[j][0],10),PKW(p[j][0],12),PKW(p[j][0],14)};
    const u32x4 pw2=(u32x4){PKW(p[j][1],0),PKW(p[j][1],2),PKW(p[j][1],4),PKW(p[j][1],6)},pw3=(u32x4){PKW(p[j][1],8),PKW(p[j][1],10),PKW(p[j][1],12),PKW(p[j][1],14)};
    #undef PKW
    SBAR(); pv(o,vb0+j*SLOTB,__builtin_bit_cast(bf16x8,pw0),__builtin_bit_cast(bf16x8,pw1),__builtin_bit_cast(bf16x8,pw2),__builtin_bit_cast(bf16x8,pw3));
  }
  if(hi==0)wsf[32+r32]=l; asm volatile("s_waitcnt lgkmcnt(0)":::"memory");
  float rli[16];
  #pragma unroll
  for(int r=0;r<16;++r)rli[r]=__builtin_amdgcn_rcpf(wsf[32+crow(r,hi)]);
  bf16*Ow=OA+(rowbase+r0)*ODM+hq*D; const bf16*Zw=PJ+(rowbase+r0)*DM+768+hq*D;
  { bf16*stg=(bf16*)(shm+LDS_OST)+wid*2048;
    #pragma unroll
    for(int r=0;r<16;++r){const int orow=crow(r,hi);
      #pragma unroll
      for(int d0=0;d0<2;++d0)stg[orow*64+d0*32+r32]=__float2bfloat16(o[d0][r]*rli[r]);}
    asm volatile("s_waitcnt lgkmcnt(0)":::"memory");
    #pragma unroll
    for(int i=0;i<4;++i){const int row=i*8+(lane>>3),ch=lane&7; const u32x4 v=*(const u32x4*)(stg+row*64+ch*8); const u32x4 zz=*(const u32x4*)(Zw+(long)row*DM+ch*8); *(u32x4*)(Ow+(long)row*ODM+ch*8)=mul_bf16x8(v,zz);} }
  asm volatile("s_waitcnt lgkmcnt(0)\n\ts_barrier":::"memory");
}
template<int THRL=8> __device__ __forceinline__ void fox_phase(char*lds,const bf16*__restrict__ PJ,bf16*__restrict__ OB,const float*__restrict__ CUM,const unsigned*__restrict__ kmax2,const unsigned*__restrict__ qmax2,int vcu,int G){
  __attribute__((address_space(3))) int* cnts=(__attribute__((address_space(3))) int*)((__attribute__((address_space(3))) char*)lds+131072+64);
  for(int L=vcu;L<1024;L+=G){ const int vc=L&255,i=L>>8,s=vc&7,bh=vc>>3; const int qb=(i==0)?s:(i==1)?15-s:(i==2)?16+s:31-s;
    const float*cumh=CUM+(long)bh*SEQ;
    { const int j=threadIdx.x; bool c=false;
      if(j<4*qb){ const float k2=__uint_as_float(kmax2[bh*2])+__uint_as_float(kmax2[bh*2+1]), q2=__uint_as_float(qmax2[(bh*32+qb)*2])+__uint_as_float(qmax2[(bh*32+qb)*2+1]);
        const float bound=2.04f*__builtin_sqrtf(k2*q2); c=(cumh[256*qb]-cumh[64*j+63])*1.4426950408889634f+bound<-152.0f; }
      const int n=__builtin_popcountll(__ballot(c)); if((threadIdx.x&63)==0&&threadIdx.x<128)cnts[threadIdx.x>>6]=n; }
    __syncthreads();
    const int t0=__builtin_amdgcn_readfirstlane((cnts[0]+cnts[1])&~1);
    __syncthreads();
    attn_unit<THRL>(bh/NHEAD,bh%NHEAD,qb,PJ+1280,PJ+1792,PJ+2304,OB,PJ+2816,cumh,t0,lds); }
}
__device__ __forceinline__ void swa_phase(char*lds,const bf16*__restrict__ PJ,bf16*__restrict__ OA,const float*__restrict__ sinks,int vcu,int G){
  for(int L=vcu;L<1024;L+=G){ const int blk=L&127,kvh=(L>>7)&1,b=L>>8; swa_unit(b,kvh,blk,PJ,OA,sinks,lds); }
}
#undef SBAR
#undef WAIT_BAR
}

constexpr int NWAVES = 8;
constexpr int BATCH = 4, SEQ = 8192, DM_ = 1024, M = BATCH * SEQ, INW = 5384, PJW = pg8::PJW;
constexpr float NORM_EPS = 1e-6f;
constexpr size_t MiB = 1u << 20;
constexpr size_t WS_CTL = 0, CTL_ZERO_BYTES = 32768;
constexpr int CW_KMAX = 4096, CW_QMAX = 4352;
constexpr size_t WS_W1T = 2 * MiB;
constexpr size_t WS_WAT = 14 * MiB;
constexpr size_t WS_WBT = 15 * MiB;
constexpr size_t WS_WOT = 16 * MiB;
constexpr size_t WS_ADAP = 18 * MiB;
constexpr size_t WS_GATE = 19 * MiB;
constexpr size_t WS_LC = 20 * MiB;
constexpr size_t WS_CT = 21 * MiB;
constexpr size_t WS_CUM = 22 * MiB;
constexpr size_t WS_ROPE = 24 * MiB;
constexpr size_t WS_RSS = 32 * MiB;
constexpr size_t WS_H = 36 * MiB;
constexpr size_t WS_MG = 100 * MiB;
constexpr size_t WS_PJ = 176 * MiB;
constexpr size_t WS_END = WS_PJ + (size_t)M * PJW * 2;
constexpr int LDS_BYTES = 147456;
static_assert(attn_body::ATTN_LDS_BYTES <= 131072 && pg8::STAGE_BYTES <= 131072, "LDS");

#define LAS __attribute__((address_space(3)))
typedef unsigned short bf16;
typedef unsigned v4u __attribute__((ext_vector_type(4)));
typedef float f32x4 __attribute__((ext_vector_type(4)));
#define LDS_WAIT() asm volatile("s_waitcnt lgkmcnt(0)" ::: "memory")
__device__ __forceinline__ unsigned f2bf(float f) { unsigned u = __builtin_bit_cast(unsigned, f); return (u + 0x7fffu + ((u >> 16) & 1u)) >> 16; }
__device__ __forceinline__ unsigned pk2(float lo, float hi) { return f2bf(lo) | (f2bf(hi) << 16); }
__device__ __forceinline__ float wave_sum(float v) {
#pragma unroll
    for (int o = 1; o < 64; o <<= 1) v += __shfl_xor(v, o);
    return v;
}
__device__ __forceinline__ int w1_src_col(int n) {
    if (n >= 2816) return n + 8;
    if (n < 640) { const int hb = n & ~63, p = n & 63; return hb + 16 * (p >> 5) + 4 * ((p >> 3) & 3) + (p & 3) + 32 * ((p >> 2) & 1); }
    return n;
}
template <bool MAP> __device__ __forceinline__ void p0_transpose_item(const float* W, int K, int Nsrc, int Nout, bf16* WT, LAS float* scr, int item, int lane) {
    const int nblk = Nout / 32, kb = item / nblk, nb = item % nblk, k0 = 64 * kb, n0 = 32 * nb;
    const int sc = MAP ? w1_src_col(n0 + (lane & 31)) : n0 + (lane & 31);
#pragma unroll 8
    for (int i = 0; i < 32; ++i) { const int kk = 2 * i + (lane >> 5); scr[kk * 33 + (lane & 31)] = W[(size_t)(k0 + kk) * Nsrc + sc]; }
    LDS_WAIT(); asm volatile("" ::: "memory");
    const int c = lane & 7;
#pragma unroll
    for (int j = 0; j < 4; ++j) { const int n = (lane >> 3) + 8 * j; const LAS float* s = scr + (8 * c) * 33 + n;
        v4u o; o.x = pk2(s[0 * 33], s[1 * 33]); o.y = pk2(s[2 * 33], s[3 * 33]); o.z = pk2(s[4 * 33], s[5 * 33]); o.w = pk2(s[6 * 33], s[7 * 33]);
        *(v4u*)(WT + (size_t)(n0 + n) * K + k0 + 8 * c) = o; }
    LDS_WAIT(); asm volatile("" ::: "memory");
}

#define XB_TMO      128
#define XB_XCNT(j)  (256  + 64 * (j))
#define XB_XSUB(j)  (1280 + 64 * (j))
#define XB_XGEN(j)  (2304 + 64 * (j))
#define XB_TOP      3328
#define XB_TOPGEN   3392
#define XCD_BAR_WORDS 3456
#define XB_SPIN_CAP (1u << 18)

__device__ __forceinline__ unsigned xb_ld(unsigned* p)              { return __hip_atomic_load(p, __ATOMIC_RELAXED, __HIP_MEMORY_SCOPE_AGENT); }
__device__ __forceinline__ unsigned xb_add(unsigned* p, unsigned v) { return __hip_atomic_fetch_add(p, v, __ATOMIC_RELAXED, __HIP_MEMORY_SCOPE_AGENT); }
__device__ __forceinline__ unsigned xb_xcc_id() { return (unsigned)__builtin_amdgcn_s_getreg((3 << 11) | 20) & 0xFu; }
#define XB_SPIN(cond, bar) do { unsigned _sp = 0; while (cond) { __builtin_amdgcn_s_sleep(1); \
    if ((++_sp & 255u) == 0u) { if (xb_ld(&(bar)[XB_TMO])) break; if (_sp > XB_SPIN_CAP) { atomicAdd(&(bar)[XB_TMO], 1u); break; } } } } while (0)

struct XcdBarrier {
    unsigned* bar; unsigned x;
    volatile LAS unsigned* st;
};

__device__ __forceinline__ XcdBarrier xcd_barrier_post(unsigned* bar, volatile LAS unsigned* st) {
    XcdBarrier b; b.bar = bar; b.x = xb_xcc_id(); b.st = st;
    if (threadIdx.x == 0) (void)xb_add(&bar[XB_XCNT(b.x)], 1u);
    return b;
}
__device__ __forceinline__ void xcd_barrier_complete(unsigned* bar, unsigned x, unsigned& nloc, unsigned& nx) {
    const unsigned G = gridDim.x * gridDim.y * gridDim.z;
    unsigned sum, cnt, mine, sp = 0u;
    for (;;) {
        sum = 0u; cnt = 0u; mine = 0u;
#pragma unroll
        for (unsigned j = 0; j < 16; ++j) { const unsigned c = xb_ld(&bar[XB_XCNT(j)]); sum += c; cnt += (c > 0u) ? 1u : 0u; mine = (j == x) ? c : mine; }
        if (sum == G) break;
        __builtin_amdgcn_s_sleep(1);
        if ((++sp & 255u) == 0u) { if (xb_ld(&bar[XB_TMO])) break; if (sp > XB_SPIN_CAP) { atomicAdd(&bar[XB_TMO], 1u); break; } }
    }
    nloc = mine > 0u ? mine : 1u; nx = cnt > 0u ? cnt : 1u;
}

__device__ __forceinline__ void xcd_barrier(const XcdBarrier& b) {
    asm volatile("s_waitcnt vmcnt(0)" ::: "memory");
    __syncthreads();
    if (threadIdx.x == 0) {
        unsigned* bar = b.bar;
        __builtin_amdgcn_s_waitcnt(0);
        unsigned nloc = b.st[0], nx = b.st[1];
        if (nloc == 0u) { xcd_barrier_complete(bar, b.x, nloc, nx); b.st[0] = nloc; b.st[1] = nx; }
        const unsigned old = xb_add(&bar[XB_XSUB(b.x)], 1u);
        const unsigned gen = old / nloc;
        if (old + 1u == (gen + 1u) * nloc) {
            __builtin_amdgcn_fence(__ATOMIC_RELEASE, "agent");
            asm volatile("s_waitcnt vmcnt(0)" ::: "memory");
            const unsigned og = xb_add(&bar[XB_TOP], 1u);
            const unsigned tg = og / nx;
            if (og + 1u == (tg + 1u) * nx) xb_add(&bar[XB_TOPGEN], 1u);
            else XB_SPIN(xb_ld(&bar[XB_TOPGEN]) == tg, bar);
            __builtin_amdgcn_fence(__ATOMIC_ACQUIRE, "agent");
            xb_add(&bar[XB_XGEN(b.x)], 1u);
            asm volatile("s_waitcnt vmcnt(0)" ::: "memory");
        } else {
            XB_SPIN(xb_ld(&bar[XB_XGEN(b.x)]) == gen, bar);
            __builtin_amdgcn_fence(__ATOMIC_ACQUIRE, "agent");
            asm volatile("s_waitcnt vmcnt(0)" ::: "memory");
        }
    }
    __syncthreads();
}

struct Args { const float *x, *c; const int* pos; const float *w_ada, *b_ada, *g_norm, *w_in, *b_f, *sinks, *w_o_swa, *w_o_fox, *w_out, *g_final; float* out; unsigned char* ws; int never; int pad; };

__global__ void __launch_bounds__(NWAVES * 64, 2) mk_fwd(Args a) {
    extern __shared__ __attribute__((aligned(16))) unsigned char lds[];
    cg::grid_group grid = cg::this_grid();
    LAS unsigned char* ldsl = (LAS unsigned char*)lds;
    const int G = gridDim.x; const int bx = blockIdx.x; const int vcu = (G % 8 == 0) ? (bx % 8) * (G / 8) + bx / 8 : bx;
    unsigned char* ws = a.ws;
    volatile LAS unsigned* MISC = (volatile LAS unsigned*)(ldsl + 131072 + 320);
    if (threadIdx.x < 32) MISC[threadIdx.x] = 0u;
    __syncthreads();
    if (a.never) grid.sync();
    XcdBarrier bar = xcd_barrier_post((unsigned*)(ws + WS_CTL), MISC + 8);
    unsigned* CTL = (unsigned*)(ws + WS_CTL);
    bf16* W1T = (bf16*)(ws + WS_W1T); bf16* WAT = (bf16*)(ws + WS_WAT); bf16* WBT = (bf16*)(ws + WS_WBT); bf16* WOT = (bf16*)(ws + WS_WOT);
    float* ADAP = (float*)(ws + WS_ADAP); float* GATE = (float*)(ws + WS_GATE); float* LC = (float*)(ws + WS_LC); float* CT = (float*)(ws + WS_CT);
    float* CUM = (float*)(ws + WS_CUM); float* ROPE = (float*)(ws + WS_ROPE); float* RSS = (float*)(ws + WS_RSS);
    bf16* H = (bf16*)(ws + WS_H); bf16* MG = (bf16*)(ws + WS_MG); bf16* PJ = (bf16*)(ws + WS_PJ);

    {
        int t_ = threadIdx.x; asm volatile("" : "+v"(t_)); const int tid = t_, lane = tid & 63, wave = __builtin_amdgcn_readfirstlane(tid >> 6); (void)tid; (void)lane; (void)wave;
        LAS float* scr = (LAS float*)(ldsl + wave * 16384);
        const int gw = vcu * NWAVES + wave, NGW = G * NWAVES;
        constexpr int I_1 = (1024 / 64) * (PJW / 32), I_A = (512 / 64) * (1024 / 32), I_O = (1024 / 64) * (1024 / 32), I_ADA = 48 * 8;
        for (int rp = 0, nrep = opaque_i(1 + PROBE_P0); rp < nrep; ++rp)
        for (int it = gw; it < I_1 + 2 * I_A + I_O + I_ADA; it += NGW) {
            int r = it;
            if (r < I_1) { p0_transpose_item<true>(a.w_in, 1024, INW, PJW, W1T, scr, r, lane); continue; } r -= I_1;
            if (r < I_A) { p0_transpose_item<false>(a.w_o_swa, 512, 1024, 1024, WAT, scr, r, lane); continue; } r -= I_A;
            if (r < I_A) { p0_transpose_item<false>(a.w_o_fox, 512, 1024, 1024, WBT, scr, r, lane); continue; } r -= I_A;
            if (r < I_O) { p0_transpose_item<false>(a.w_out, 1024, 1024, 1024, WOT, scr, r, lane); continue; } r -= I_O;
            { const int cc = r % 48, ks = r / 48, col = cc * 64 + lane; float s0 = 0.f, s1 = 0.f, s2 = 0.f, s3 = 0.f;
              for (int k = ks * 128; k < ks * 128 + 128; ++k) { const float w = a.w_ada[(size_t)k * 3072 + col]; s0 += a.c[k] * w; s1 += a.c[1024 + k] * w; s2 += a.c[2048 + k] * w; s3 += a.c[3072 + k] * w; }
              float* o = ADAP + (size_t)ks * 4 * 3072 + col; o[0] = s0; o[3072] = s1; o[2 * 3072] = s2; o[3 * 3072] = s3; }
        }
    }
    xcd_barrier(bar);

    for (int rp = 0, nrep = opaque_i(PROBE_SYNC); rp < nrep; ++rp) xcd_barrier(bar);
    {
        int t_ = threadIdx.x; asm volatile("" : "+v"(t_)); const int tid = t_, lane = tid & 63, wave = __builtin_amdgcn_readfirstlane(tid >> 6); (void)tid; (void)lane; (void)wave;
        LAS float* gsL = (LAS float*)ldsl; LAS float* shL = gsL + 1024; LAS f32x4* wfL = (LAS f32x4*)(ldsl + 8192);
        for (int q = tid; q < 2048; q += NWAVES * 64) { const int ln = q & 63, hf = (q >> 6) & 1, je = q >> 7, col = 256 * (je >> 2) + 4 * ln + (je & 3);
            wfL[q] = *((const f32x4*)(a.w_in + (size_t)col * INW + 2816) + hf); }
        for (int rp = 0, nrep = opaque_i(1 + PROBE_P1); rp < nrep; ++rp)
        for (int rb = bx; rb < M / 128; rb += G) {
            const int b = rb / 64;
            for (int c = tid; c < 2048; c += NWAVES * 64) { float v = a.b_ada[c];
#pragma unroll
                for (int ks = 0; ks < 8; ++ks) v += ADAP[(size_t)(ks * 4 + b) * 3072 + c];
                if (c < 1024) shL[c] = v; else gsL[c - 1024] = a.g_norm[c - 1024] * (1.0f + v); }
            if ((rb & 63) == 0) for (int c = tid; c < 1024; c += NWAVES * 64) { float v = a.b_ada[2048 + c];
#pragma unroll
                for (int ks = 0; ks < 8; ++ks) v += ADAP[(size_t)(ks * 4 + b) * 3072 + 2048 + c];
                GATE[b * 1024 + c] = v; }
            __syncthreads();
            const int hsel = 4 * ((lane >> 5) & 1) + 2 * ((lane >> 4) & 1) + ((lane >> 3) & 1);
            float run = 0.f; const float bfl = a.b_f[hsel];
            const float invf = __builtin_powf(10000.0f, -(float)(lane & 31) * (1.0f / 32.0f));
            const int rowb = rb * 128 + wave * 16;
            f32x4 vn[2][4];
#pragma unroll
            for (int u = 0; u < 2; ++u)
#pragma unroll
                for (int j = 0; j < 4; ++j) vn[u][j] = *((const f32x4*)(a.x + (size_t)(rowb + u) * 1024) + lane + 64 * j);
            for (int ip = 0; ip < 8; ++ip) {
                f32x4 v[2][4];
#pragma unroll
                for (int u = 0; u < 2; ++u)
#pragma unroll
                    for (int j = 0; j < 4; ++j) v[u][j] = vn[u][j];
                if (ip < 7) {
#pragma unroll
                    for (int u = 0; u < 2; ++u)
#pragma unroll
                        for (int j = 0; j < 4; ++j) vn[u][j] = *((const f32x4*)(a.x + (size_t)(rowb + 2 * ip + 2 + u) * 1024) + lane + 64 * j);
                }
                float ssq[2], fr_[2];
#pragma unroll
                for (int u = 0; u < 2; ++u) { float s = 0.f;
#pragma unroll
                    for (int j = 0; j < 4; ++j) s += (v[u][j][0] * v[u][j][0] + v[u][j][1] * v[u][j][1]) + (v[u][j][2] * v[u][j][2] + v[u][j][3] * v[u][j][3]);
                    ssq[u] = s; }
#pragma unroll
                for (int o = 1; o < 64; o <<= 1) { ssq[0] += __shfl_xor(ssq[0], o); ssq[1] += __shfl_xor(ssq[1], o); }
                float rs2[2], f[2][8];
#pragma unroll
                for (int u = 0; u < 2; ++u) { rs2[u] = 1.0f / sqrtf(ssq[u] * (1.0f / 1024.0f) + NORM_EPS);
#pragma unroll
                    for (int hh = 0; hh < 8; ++hh) f[u][hh] = 0.f; }
#pragma unroll
                for (int j = 0; j < 4; ++j) {
                    asm volatile("" ::: "memory");
                    f32x4 w0[4], w1[4]; const f32x4 gsj = *(const LAS f32x4*)(gsL + 256 * j + 4 * lane), shj = *(const LAS f32x4*)(shL + 256 * j + 4 * lane);
#pragma unroll
                    for (int e = 0; e < 4; ++e) { w0[e] = wfL[((j * 4 + e) * 2) * 64 + lane]; w1[e] = wfL[((j * 4 + e) * 2 + 1) * 64 + lane]; }
#pragma unroll
                    for (int u = 0; u < 2; ++u) { const int row = rowb + 2 * ip + u;
                        v[u][j] = v[u][j] * rs2[u] * gsj + shj;
                        *((unsigned long long*)(H + (size_t)row * 1024) + lane + 64 * j) = (unsigned long long)pk2(v[u][j][0], v[u][j][1]) | ((unsigned long long)pk2(v[u][j][2], v[u][j][3]) << 32);
#pragma unroll
                        for (int e = 0; e < 4; ++e) { const float hv = v[u][j][e];
                            f[u][0] += hv * w0[e][0]; f[u][1] += hv * w0[e][1]; f[u][2] += hv * w0[e][2]; f[u][3] += hv * w0[e][3]; f[u][4] += hv * w1[e][0]; f[u][5] += hv * w1[e][1]; f[u][6] += hv * w1[e][2]; f[u][7] += hv * w1[e][3]; } }
                }
#pragma unroll
                for (int u = 0; u < 2; ++u) {
                    const int row = rowb + 2 * ip + u;
                    const bool u5 = lane & 32, u4 = lane & 16, u3 = lane & 8;
                    float g4[4], h2[2];
#pragma unroll
                    for (int k = 0; k < 4; ++k) { const float keep = u5 ? f[u][k + 4] : f[u][k], send = u5 ? f[u][k] : f[u][k + 4]; g4[k] = keep + __shfl_xor(send, 32); }
#pragma unroll
                    for (int k = 0; k < 2; ++k) { const float keep = u4 ? g4[k + 2] : g4[k], send = u4 ? g4[k] : g4[k + 2]; h2[k] = keep + __shfl_xor(send, 16); }
                    float r1; { const float keep = u3 ? h2[1] : h2[0], send = u3 ? h2[0] : h2[1]; r1 = keep + __shfl_xor(send, 8); }
                    r1 += __shfl_xor(r1, 4); r1 += __shfl_xor(r1, 2); r1 += __shfl_xor(r1, 1);
                    fr_[u] = r1;
                    if (lane < 32) { const float ang = (float)a.pos[row] * invf; const float kq = rintf(ang * 0.15915494309189535f);
                        float r = fmaf(-kq, 6.2831854820251465f, ang); r = fmaf(-kq, -1.7484555314695172e-07f, r);
                        typedef float f32x2 __attribute__((ext_vector_type(2)));
                        *((f32x2*)(ROPE + (size_t)row * 64) + lane) = (f32x2){__cosf(r), __sinf(r)}; }
                }
#pragma unroll
                for (int u = 0; u < 2; ++u) { const int row = rowb + 2 * ip + u; const float z = fr_[u] + bfl; const float lf = fminf(z, 0.f) - log1pf(expf(-fabsf(z))); run += lf;
                    if ((lane & 7) == 0) { LC[(size_t)row * 8 + hsel] = run; if (ip == 7 && u == 1) CT[(size_t)(row >> 4) * 8 + hsel] = run; } }
            }
            __syncthreads();
        }
    }
    xcd_barrier(bar);

    {
        int t_ = threadIdx.x; asm volatile("" : "+v"(t_)); const int tid = t_, lane = tid & 63, wave = __builtin_amdgcn_readfirstlane(tid >> 6); (void)tid; (void)lane; (void)wave;
        LAS float* red = (LAS float*)ldsl;
        for (int rb = bx; rb < M / 128; rb += G) {
            const int b = rb / 64, c0 = rb * 8, npc = c0 - b * 512;
            float pv8[8];
            { f32x4 p0 = (f32x4){0.f, 0.f, 0.f, 0.f}, p1 = p0; if (tid < npc) { const f32x4* cp = (const f32x4*)(CT + (size_t)(b * 512 + tid) * 8); p0 = cp[0]; p1 = cp[1]; }
              pv8[0] = p0[0]; pv8[1] = p0[1]; pv8[2] = p0[2]; pv8[3] = p0[3]; pv8[4] = p1[0]; pv8[5] = p1[1]; pv8[6] = p1[2]; pv8[7] = p1[3]; }
            __syncthreads();
#pragma unroll
            for (int hh = 0; hh < 8; ++hh) { const float s = wave_sum(pv8[hh]); if (lane == 0) red[wave * 8 + hh] = s; }
            __syncthreads();
            { const int r = tid >> 2, h0 = 2 * (tid & 3), row = rb * 128 + r, cc = r >> 4;
#pragma unroll
              for (int e = 0; e < 2; ++e) { const int hh = h0 + e; float base = 0.f;
#pragma unroll
                  for (int w = 0; w < 8; ++w) base += red[w * 8 + hh];
                  for (int c = 0; c < cc; ++c) base += CT[(size_t)(c0 + c) * 8 + hh];
                  CUM[(size_t)(b * 8 + hh) * SEQ + (row - b * SEQ)] = base + LC[(size_t)row * 8 + hh]; } }
            __syncthreads();
        }
        pg8::Gemm g{H, W1T, H, W1T, 1024, M, PJW, 1024}; pg8::StaticOrder S; S.init(M, PJW, G, bx, 1);
        pg8::EpiProj E{PJ, ROPE, CTL + CW_KMAX, CTL + CW_QMAX};
        for (int rp = 0, nrep = opaque_i(1 + PROBE_P2); rp < nrep; ++rp) pg8::gemm_phase<pg8::EpiProj, pg8::StaticOrder, true, true>(ldsl, g, S, E);
    }
    xcd_barrier(bar);

    for (int rp = 0, nrep = opaque_i(1 + PROBE_SWA); rp < nrep; ++rp) attn_body::swa_phase((char*)lds, (const attn_body::bf16*)PJ, (attn_body::bf16*)H, a.sinks, vcu, G);
    for (int rp = 0, nrep = opaque_i(1 + PROBE_FOX); rp < nrep; ++rp) attn_body::fox_phase<8>((char*)lds, (const attn_body::bf16*)PJ, (attn_body::bf16*)H + 512, CUM, CTL + CW_KMAX, CTL + CW_QMAX, vcu, G);
    xcd_barrier(bar);

    {
        pg8::Gemm g{H, WAT, H + 512, WBT, 1024, M, 1024, 512}; pg8::StaticOrder S; S.init(M, 1024, G, bx, 2);
        pg8::EpiMerge E{PJ, MG};
        for (int rp = 0, nrep = opaque_i(1 + PROBE_P4); rp < nrep; ++rp) pg8::gemm_phase<pg8::EpiMerge, pg8::StaticOrder, true, true>(ldsl, g, S, E);
    }
    xcd_barrier(bar);

    {
        pg8::Gemm g{MG, WOT, MG, WOT, 1024, M, 1024, 1024}; pg8::StaticOrder S; S.init(M, 1024, G, bx, 1);
        pg8::EpiOut E{a.x, GATE, a.out, RSS};
        for (int rp = 0, nrep = opaque_i(1 + PROBE_P5); rp < nrep; ++rp) pg8::gemm_phase<pg8::EpiOut, pg8::StaticOrder, true, true>(ldsl, g, S, E);
    }
    xcd_barrier(bar);

    {
        int t_ = threadIdx.x; asm volatile("" : "+v"(t_)); const int tid = t_, lane = tid & 63, wave = __builtin_amdgcn_readfirstlane(tid >> 6); (void)tid; (void)lane; (void)wave;
        const int gw = bx * NWAVES + wave, NGW = G * NWAVES;
        f32x4 gf[4];
#pragma unroll
        for (int j = 0; j < 4; ++j) gf[j] = *((const f32x4*)a.g_final + 64 * j + lane);
        for (int row = gw; row < M; row += NGW) {
            float s = RSS[(size_t)row * 16 + (lane & 15)];
            s += __shfl_xor(s, 1); s += __shfl_xor(s, 2); s += __shfl_xor(s, 4); s += __shfl_xor(s, 8);
            const float rs = 1.0f / sqrtf(s * (1.0f / 1024.0f) + NORM_EPS);
            f32x4* o = (f32x4*)(a.out + (size_t)row * 1024) + lane;
#pragma unroll
            for (int j = 0; j < 4; ++j) o[64 * j] = o[64 * j] * rs * gf[j];
        }
    }
}

extern "C" void kernel_launch(void* const* d_in, const int* in_sizes, int n_in, void* d_out, int out_size, void* d_ws, size_t ws_size, hipStream_t stream) {
    static int grid = 0;
    if (grid == 0) {
        if (n_in != 13 || out_size != M * 1024 || ws_size < WS_END) { fprintf(stderr, "kernel_launch: unexpected problem (n_in %d, out %d, ws %zu)\n", n_in, out_size, ws_size); grid = -1; return; }
        int dev = 0, cus = 0, per_cu = 0;
        (void)hipGetDevice(&dev);
        (void)hipDeviceGetAttribute(&cus, hipDeviceAttributeMultiprocessorCount, dev);
        (void)hipFuncSetAttribute((const void*)mk_fwd, hipFuncAttributeMaxDynamicSharedMemorySize, LDS_BYTES);
        (void)hipOccupancyMaxActiveBlocksPerMultiprocessor(&per_cu, (const void*)mk_fwd, NWAVES * 64, LDS_BYTES);
        if (per_cu < 1) { fprintf(stderr, "kernel_launch: occupancy query reports %d\n", per_cu); grid = -1; return; }
        grid = cus;
    }
    if (grid < 0) return;
    if (hipMemsetAsync((char*)d_ws + WS_CTL, 0, CTL_ZERO_BYTES, stream) != hipSuccess) { fprintf(stderr, "kernel_launch: memset failed\n"); return; }
    Args a{};
    a.x = (const float*)d_in[0]; a.c = (const float*)d_in[1]; a.pos = (const int*)d_in[2]; a.w_ada = (const float*)d_in[3]; a.b_ada = (const float*)d_in[4]; a.g_norm = (const float*)d_in[5];
    a.w_in = (const float*)d_in[6]; a.b_f = (const float*)d_in[7]; a.sinks = (const float*)d_in[8]; a.w_o_swa = (const float*)d_in[9]; a.w_o_fox = (const float*)d_in[10]; a.w_out = (const float*)d_in[11];
    a.g_final = (const float*)d_in[12]; a.out = (float*)d_out; a.ws = (unsigned char*)d_ws;
    void* args[] = {&a};
    hipError_t e = hipLaunchCooperativeKernel((void*)mk_fwd, dim3(grid), dim3(NWAVES * 64), args, LDS_BYTES, stream);
    if (e != hipSuccess) fprintf(stderr, "kernel_launch: cooperative launch failed: %s (grid %d)\n", hipGetErrorString(e), grid);
}
```
